# Optimizing an MI355X kernel written in HIP

```python
import math
import jax, jax.numpy as jnp
from jax import lax
import numpy as np

D_MODEL = 1024
BATCH = 8
SEQ = 2048
DEPTH = 1
DEC_BATCH = 128
DEC_SEQ = 1
PAST_LEN = 16384
PAGE_SIZE = 128

D_MIX = 2 * D_MODEL
SSD_WIDTH = (3 * D_MIX) // 4
SSD_HEAD_DIM = 64
SSD_HEADS = SSD_WIDTH // SSD_HEAD_DIM
SSD_GROUPS = 4
SSD_HEADS_PER_GROUP = SSD_HEADS // SSD_GROUPS
SSD_STATE = 64
SSD_CONV_W = 4
SSD_CHUNK = 128
CONV_DIM = SSD_WIDTH + 2 * SSD_GROUPS * SSD_STATE
POOL_WIDTH = D_MIX - SSD_WIDTH
POOL_WINDOWS = (2, 4, 8, 16)
POOL_GROUPS = len(POOL_WINDOWS)
POOL_GROUP_DIM = POOL_WIDTH // POOL_GROUPS
POOL_MAX = max(POOL_WINDOWS)
D_FF = 128 * ((8 * D_MODEL // 3 + 127) // 128)
FFN_CONV_W = 3
IN_COLS = SSD_WIDTH + CONV_DIM + SSD_HEADS + POOL_WIDTH
EPS = 1e-6

kernel_name = "hymba_ssd_pool_convffn_step"


def rmsnorm(x, w):
    xf = x.astype(jnp.float32)
    y = xf * lax.rsqrt(jnp.mean(xf * xf, axis=-1, keepdims=True) + EPS) * w.astype(jnp.float32)
    return y.astype(x.dtype)


def causal_dwconv(u, buf, w, b):
    K = w.shape[0]
    T = u.shape[1]
    ext = jnp.concatenate([buf.astype(u.dtype), u], axis=1)
    out = b
    for k in range(K):
        out = out + ext[:, k:k + T] * w[k]
    return out, ext[:, ext.shape[1] - (K - 1):]


def pad_time(arr, pad):
    return jnp.pad(arr, [(0, 0), (0, pad)] + [(0, 0)] * (arr.ndim - 2))


def ssd_scan(x, dt, a, bm, cm, h0):
    f32 = jnp.float32
    bsz, T = x.shape[0], x.shape[1]
    G, R, P, N = SSD_GROUPS, SSD_HEADS_PER_GROUP, SSD_HEAD_DIM, SSD_STATE
    Q = min(SSD_CHUNK, T)
    pad = (-T) % Q
    if pad:
        x, dt, bm, cm = pad_time(x, pad), pad_time(dt, pad), pad_time(bm, pad), pad_time(cm, pad)
    nc = (T + pad) // Q
    xc = x.astype(f32).reshape(bsz, nc, Q, G, R, P)
    dtc = dt.astype(f32).reshape(bsz, nc, Q, G, R)
    bc = bm.astype(f32).reshape(bsz, nc, Q, G, N)
    cc = cm.astype(f32).reshape(bsz, nc, Q, G, N)
    acum = jnp.cumsum(dtc * a.reshape(G, R), axis=2)
    diff = acum[:, :, :, None] - acum[:, :, None]
    causal = jnp.tril(jnp.ones((Q, Q), dtype=bool))[:, :, None, None]
    decay = jnp.exp(jnp.where(causal, diff, -jnp.inf))
    cb = jnp.einsum('bclgn,bcsgn->bclsg', cc, bc)
    mix = cb[..., None] * decay * dtc[:, :, None]
    y_diag = jnp.einsum('bclsgr,bcsgrp->bclgrp', mix, xc)
    decay_to_end = jnp.exp(acum[:, :, -1:] - acum)
    chunk_states = jnp.einsum('bclgn,bclgr,bclgrp->bcgrpn', bc, decay_to_end * dtc, xc)
    chunk_decay = jnp.exp(acum[:, :, -1])

    def step(h, inp):
        cs, cd = inp
        return cd[..., None, None] * h + cs, h

    h_init = h0.astype(f32).reshape(bsz, G, R, P, N)
    h_final, h_in = lax.scan(step, h_init,
                             (jnp.moveaxis(chunk_states, 1, 0), jnp.moveaxis(chunk_decay, 1, 0)))
    h_in = jnp.moveaxis(h_in, 0, 1)
    y_off = jnp.einsum('bclgn,bcgrpn,bclgr->bclgrp', cc, h_in, jnp.exp(acum))
    y = (y_diag + y_off).reshape(bsz, nc * Q, SSD_HEADS, P)[:, :T]
    return y, h_final.reshape(bsz, SSD_HEADS, P, N)


def pool_mixer(v, buf, pos0, pool_w, pool_scale):
    f32 = jnp.float32
    bsz, T = v.shape[0], v.shape[1]
    P = POOL_MAX - 1
    ext = jnp.concatenate([buf.astype(v.dtype), v], axis=1)
    cs = jnp.cumsum(ext.astype(f32), axis=1)
    cs = jnp.concatenate([jnp.zeros((bsz, 1, POOL_WIDTH), f32), cs], axis=1)
    pos = pos0 + jnp.arange(T, dtype=jnp.int32)
    vf = v.astype(f32)
    outs = []
    for g, w in enumerate(POOL_WINDOWS):
        c0, c1 = g * POOL_GROUP_DIM, (g + 1) * POOL_GROUP_DIM
        win_sum = cs[:, P + 1:P + 1 + T, c0:c1] - cs[:, P + 1 - w:P + 1 - w + T, c0:c1]
        cnt = jnp.minimum(pos + 1, w).astype(f32)[None, :, None]
        outs.append(win_sum / cnt - vf[:, :, c0:c1])
    m = jnp.stack(outs, axis=2)
    y = jnp.einsum('btgc,gcd->btgd', m, pool_w.astype(f32)).reshape(bsz, T, POOL_WIDTH)
    y = y * pool_scale.astype(f32)
    return y.astype(v.dtype), ext[:, ext.shape[1] - P:]


def hybrid_layer(x, pos0, h0, conv_buf, pool_buf, ffn_buf,
                 norm1_w, w_in, conv_w, conv_b, dt_bias, a_log, d_skip, ssd_norm_w,
                 pool_w, pool_scale, w_out, norm2_w, w_up, ffn_conv_w, ffn_conv_b, w_down):
    f32 = jnp.float32
    bsz, T, _ = x.shape
    hn = rmsnorm(x, norm1_w)
    proj = hn @ w_in
    z, xbc, dt_raw, v = jnp.split(
        proj, [SSD_WIDTH, SSD_WIDTH + CONV_DIM, SSD_WIDTH + CONV_DIM + SSD_HEADS], axis=-1)
    xbc, conv_new = causal_dwconv(xbc, conv_buf, conv_w, conv_b)
    xbc = jax.nn.silu(xbc)
    xs, bm, cm = jnp.split(xbc, [SSD_WIDTH, SSD_WIDTH + SSD_GROUPS * SSD_STATE], axis=-1)
    xs = xs.reshape(bsz, T, SSD_HEADS, SSD_HEAD_DIM)
    bm = bm.reshape(bsz, T, SSD_GROUPS, SSD_STATE)
    cm = cm.reshape(bsz, T, SSD_GROUPS, SSD_STATE)
    dt = jax.nn.softplus(dt_raw.astype(f32) + dt_bias.astype(f32))
    a = -jnp.exp(a_log.astype(f32))
    y_ssd, h_new = ssd_scan(xs, dt, a, bm, cm, h0)
    y_ssd = y_ssd + d_skip.astype(f32)[:, None] * xs.astype(f32)
    y_ssd = y_ssd.reshape(bsz, T, SSD_WIDTH) * jax.nn.silu(z.astype(f32))
    y_ssd = rmsnorm(y_ssd.reshape(bsz, T, SSD_GROUPS, SSD_WIDTH // SSD_GROUPS),
                    ssd_norm_w.reshape(SSD_GROUPS, SSD_WIDTH // SSD_GROUPS))
    y_ssd = y_ssd.reshape(bsz, T, SSD_WIDTH).astype(x.dtype)
    y_pool, pool_new = pool_mixer(v, pool_buf, pos0, pool_w, pool_scale)
    x = x + jnp.concatenate([y_ssd, y_pool], axis=-1) @ w_out
    hn = rmsnorm(x, norm2_w)
    u = hn @ w_up
    u, ffn_new = causal_dwconv(u, ffn_buf, ffn_conv_w, ffn_conv_b)
    gate, val = jnp.split(u, 2, axis=-1)
    x = x + (jax.nn.silu(gate) * val) @ w_down
    return x, h_new.astype(x.dtype), conv_new, pool_new, ffn_new


def setup_inputs(seed: int = 0) -> dict:
    key = jax.random.key(seed)
    ks = jax.random.split(key, 24)
    f32 = jnp.float32
    L = DEPTH

    def nrm(k, shape, scale):
        return jax.random.normal(k, shape, f32) * scale

    dt0 = jnp.exp(jax.random.uniform(ks[10], (L, SSD_HEADS), f32, math.log(1e-3), math.log(1e-1)))
    return {
        "x_prompt": nrm(ks[0], (BATCH, SEQ, D_MODEL), 1.0),
        "x_sample": nrm(ks[1], (DEC_BATCH, DEC_SEQ, D_MODEL), 1.0),
        "state_ssm": nrm(ks[2], (L, DEC_BATCH, SSD_HEADS, SSD_HEAD_DIM, SSD_STATE), 0.1),
        "state_conv": nrm(ks[3], (L, DEC_BATCH, SSD_CONV_W - 1, CONV_DIM), 1.0),
        "state_pool": nrm(ks[4], (L, DEC_BATCH, POOL_MAX - 1, POOL_WIDTH), 1.0),
        "state_ffn_conv": nrm(ks[5], (L, DEC_BATCH, FFN_CONV_W - 1, 2 * D_FF), 1.0),
        "norm1_w": 1.0 + nrm(ks[6], (L, D_MODEL), 0.02),
        "w_in": nrm(ks[7], (L, D_MODEL, IN_COLS), D_MODEL ** -0.5),
        "conv_w": nrm(ks[8], (L, SSD_CONV_W, CONV_DIM), SSD_CONV_W ** -0.5),
        "conv_b": nrm(ks[9], (L, CONV_DIM), 0.02),
        "dt_bias": dt0 + jnp.log(-jnp.expm1(-dt0)),
        "a_log": jnp.log(jax.random.uniform(ks[11], (L, SSD_HEADS), f32, 1.0, 16.0)),
        "d_skip": 1.0 + nrm(ks[12], (L, SSD_HEADS), 0.1),
        "ssd_norm_w": 1.0 + nrm(ks[13], (L, SSD_WIDTH), 0.02),
        "pool_w": nrm(ks[14], (L, POOL_GROUPS, POOL_GROUP_DIM, POOL_GROUP_DIM), POOL_GROUP_DIM ** -0.5),
        "pool_scale": 1.0 + nrm(ks[15], (L, POOL_WIDTH), 0.1),
        "w_out": nrm(ks[16], (L, D_MIX, D_MODEL), D_MIX ** -0.5),
        "norm2_w": 1.0 + nrm(ks[17], (L, D_MODEL), 0.02),
        "w_up": nrm(ks[18], (L, D_MODEL, 2 * D_FF), D_MODEL ** -0.5),
        "ffn_conv_w": nrm(ks[19], (L, FFN_CONV_W, 2 * D_FF), FFN_CONV_W ** -0.5),
        "ffn_conv_b": nrm(ks[20], (L, 2 * D_FF), 0.02),
        "w_down": nrm(ks[21], (L, D_FF, D_MODEL), D_FF ** -0.5),
        "final_norm_w": 1.0 + nrm(ks[22], (D_MODEL,), 0.02),
    }


def reference(x_prompt, x_sample, state_ssm, state_conv, state_pool, state_ffn_conv,
              norm1_w, w_in, conv_w, conv_b, dt_bias, a_log, d_skip, ssd_norm_w,
              pool_w, pool_scale, w_out, norm2_w, w_up, ffn_conv_w, ffn_conv_b, w_down,
              final_norm_w):
    dtp = x_prompt.dtype
    xp, xs = x_prompt, x_sample
    ssm_p, ssm_s, conv_p, conv_s, pool_p, pool_s, ffn_p, ffn_s = [], [], [], [], [], [], [], []
    for l in range(DEPTH):
        params = (norm1_w[l], w_in[l], conv_w[l], conv_b[l], dt_bias[l], a_log[l], d_skip[l],
                  ssd_norm_w[l], pool_w[l], pool_scale[l], w_out[l], norm2_w[l], w_up[l],
                  ffn_conv_w[l], ffn_conv_b[l], w_down[l])
        xp, hp, cp, pp, fp = hybrid_layer(
            xp, 0,
            jnp.zeros((BATCH, SSD_HEADS, SSD_HEAD_DIM, SSD_STATE), dtp),
            jnp.zeros((BATCH, SSD_CONV_W - 1, CONV_DIM), dtp),
            jnp.zeros((BATCH, POOL_MAX - 1, POOL_WIDTH), dtp),
            jnp.zeros((BATCH, FFN_CONV_W - 1, 2 * D_FF), dtp),
            *params)
        xs, hs, cs_, ps, fs = hybrid_layer(
            xs, PAST_LEN, state_ssm[l], state_conv[l], state_pool[l], state_ffn_conv[l], *params)
        ssm_p.append(hp); ssm_s.append(hs)
        conv_p.append(cp); conv_s.append(cs_)
        pool_p.append(pp); pool_s.append(ps)
        ffn_p.append(fp); ffn_s.append(fs)
    y_prompt = rmsnorm(xp, final_norm_w)
    y_sample = rmsnorm(xs, final_norm_w)
    return (y_prompt, y_sample,
            jnp.stack(ssm_p), jnp.stack(ssm_s),
            jnp.stack(conv_p), jnp.stack(conv_s),
            jnp.stack(pool_p), jnp.stack(pool_s),
            jnp.stack(ffn_p), jnp.stack(ffn_s))
```

```cpp
#include <hip/hip_runtime.h>
#include <cstdio>
#include <cstdint>
namespace pg8 {
#define PG8_LAS __attribute__((address_space(3)))
typedef unsigned short bf16_t;
typedef short bf16x8 __attribute__((ext_vector_type(8)));
typedef float f32x4 __attribute__((ext_vector_type(4)));
typedef unsigned u32x4 __attribute__((ext_vector_type(4)));
constexpr int BM = 256, BK = 64, HALF = 128, HTB = HALF * BK * 2  , STAGE_BYTES = 8 * HTB, NXCD = 8, WGM = 8;

__host__ __device__ __forceinline__ int lds_byte(int r, int c) { const int st = (r >> 4) * 2 + (c >> 5), rr = r & 15, cc = c & 31, ob = rr * 64 + cc * 2; return st * 1024 + (ob ^ (((ob >> 9) & 1) << 5)); }
__host__ __device__ __forceinline__ void stage_rc(int b, int& R, int& C) { const int st = b / 1024, sb = b % 1024, swz = sb ^ (((sb >> 9) & 1) << 5); R = (st >> 1) * 16 + swz / 64; C = (st & 1) * 32 + (swz % 64) / 2; }
__host__ __device__ __forceinline__ int perm32(int rho) { const int n = rho >> 4, i = rho & 15; return 8 * (i >> 2) + 4 * n + (i & 3); }

struct Unit { int pm, pn; };
struct Gemm { const bf16_t* A; const bf16_t* Bt; int M, N, K; };

struct StaticOrder {
    int nM, nN, nwg, G, c;
    __host__ __device__ void init(int M, int N, int G_, int c_) { nM = M / BM; nN = N / BM; nwg = nM * nN; G = G_; c = c_; }
    __host__ __device__ bool next(int i, Unit& u) const {
        const long L = (long)i * G + c; if (L >= nwg) return false;
        int wgid = (int)L; { const int q = nwg / NXCD, r = nwg % NXCD, xcd = wgid % NXCD, off = wgid / NXCD; wgid = (xcd < r ? xcd * (q + 1) : r * (q + 1) + (xcd - r) * q) + off; }
        const int nig = WGM * nN, gid = wgid / nig, fm = gid * WGM, gsz = (nM - fm) < WGM ? (nM - fm) : WGM;
        u.pm = fm + ((wgid % nig) % gsz); u.pn = (wgid % nig) / gsz; return true;
    }
    __device__ __forceinline__ void a_ready(const Unit&) const {}
    __device__ __forceinline__ void done(const Unit&) const {}
};

__device__ __forceinline__ unsigned cvt_pk_bf16(float lo, float hi) { unsigned r; asm volatile("v_cvt_pk_bf16_f32 %0, %1, %2" : "=v"(r) : "v"(lo), "v"(hi)); return r; }
typedef float f32x2 __attribute__((ext_vector_type(2)));
typedef unsigned u32x2 __attribute__((ext_vector_type(2)));
__device__ __forceinline__ float silu_f(float x) { return x * __builtin_amdgcn_rcpf(1.0f + __expf(-x)); }
__device__ __forceinline__ float dpp_ror1(float v) { return __builtin_bit_cast(float, __builtin_amdgcn_update_dpp(0, __builtin_bit_cast(int, v), 0x121, 0xf, 0xf, false)); }
__device__ __forceinline__ float dpp_ror2(float v) { return __builtin_bit_cast(float, __builtin_amdgcn_update_dpp(0, __builtin_bit_cast(int, v), 0x122, 0xf, 0xf, false)); }

struct EpiStoreBf16 {
    static constexpr bool PERM = true, AFTER_DRAIN = false;
    bf16_t* O; int ldc;
    __device__ __forceinline__ void operator()(f32x4 (&acc)[2][2][4][2], const Unit& u, int wr, int wc, int fr, int fq) const {
        const int row0 = u.pm * BM + wr * 64 + fr, col0 = u.pn * BM + wc * 32 + 8 * fq;
#pragma unroll
        for (int ai = 0; ai < 2; ++ai)
#pragma unroll
            for (int m = 0; m < 4; ++m) { bf16_t* rowp = O + (size_t)(row0 + ai * HALF + m * 16) * ldc + col0;
#pragma unroll
                for (int bj = 0; bj < 2; ++bj) { const f32x4 v0 = acc[ai][bj][m][0], v1 = acc[ai][bj][m][1];
                    u32x4 w; w.x = cvt_pk_bf16(v0[0], v0[1]); w.y = cvt_pk_bf16(v0[2], v0[3]); w.z = cvt_pk_bf16(v1[0], v1[1]); w.w = cvt_pk_bf16(v1[2], v1[3]);
                    *(u32x4*)(rowp + bj * HALF) = w; } }
    }
};

template <bool WITH_BF16> struct EpiResid {
    static constexpr bool PERM = false, AFTER_DRAIN = false;
    const float* xin; float* xo; bf16_t* xb; float* ssp;
    __device__ __forceinline__ void operator()(f32x4 (&acc)[2][2][4][2], const Unit& u, int wr, int wc, int fr, int fq) const {
        const int row0 = u.pm * BM + wr * 64 + fr, col0 = u.pn * BM + wc * 32 + 4 * fq;
#pragma unroll
        for (int ai = 0; ai < 2; ++ai)
#pragma unroll
            for (int m = 0; m < 4; ++m) { const int row = row0 + ai * HALF + m * 16; float ss = 0.f;
#pragma unroll
                for (int bj = 0; bj < 2; ++bj)
#pragma unroll
                    for (int n = 0; n < 2; ++n) { const size_t off = (size_t)row * 1024 + col0 + bj * HALF + n * 16;
                        const f32x4 v = acc[ai][bj][m][n] + *(const f32x4*)(xin + off);
                        *(f32x4*)(xo + off) = v; ss += (v[0] * v[0] + v[1] * v[1]) + (v[2] * v[2] + v[3] * v[3]);
                        if (WITH_BF16) { u32x2 w; w.x = cvt_pk_bf16(v[0], v[1]); w.y = cvt_pk_bf16(v[2], v[3]); *(u32x2*)(xb + off) = w; } }
                ss += __shfl_xor(ss, 16); ss += __shfl_xor(ss, 32);
                if (fq == 0) ssp[(size_t)row * 16 + u.pn * 4 + wc] = ss; }
    }
};

template <size_t OFF_H, size_t OFF_UT, size_t OFF_UH, size_t OFF_SSP, size_t OFF_CW> struct EpiUp {
    static constexpr bool PERM = true, AFTER_DRAIN = false;    unsigned char* ws; float* ffn_out; PG8_LAS float* ex;
    __device__ __forceinline__ void operator()(f32x4 (&acc)[2][2][4][2], const Unit& u, int wr, int wc, int fr_, int fq_) const {
        int t_; asm volatile("v_mbcnt_lo_u32_b32 %0, -1, 0\n\tv_mbcnt_hi_u32_b32 %0, -1, %0" : "=v"(t_)); const int fr = t_ & 15, fq = (t_ >> 4) & 3;
        const float* ssp = (const float*)(ws + OFF_SSP); bf16_t* H = (bf16_t*)(ws + OFF_H); float* UT = (float*)(ws + OFF_UT); float* UH = (float*)(ws + OFF_UH);
        const float* cw = (const float*)(ws + OFF_CW); const float* cb = cw + 3 * 5632;
        const int row0 = u.pm * BM + wr * 64 + fr;
        const int colt = wc * 32 + 8 * fq;
#pragma unroll
        for (int ai = 0; ai < 2; ++ai)
#pragma unroll
            for (int m = 0; m < 4; ++m) { const int row = row0 + ai * HALF + m * 16;
                const f32x4 p = *(const f32x4*)(ssp + (size_t)row * 16 + 4 * fq); float s = (p[0] + p[1]) + (p[2] + p[3]);
                s += __builtin_bit_cast(float, __builtin_amdgcn_ds_bpermute((t_ ^ 16) << 2, __builtin_bit_cast(int, s)));
                s += __builtin_bit_cast(float, __builtin_amdgcn_ds_bpermute((t_ ^ 32) << 2, __builtin_bit_cast(int, s)));
                const float rs = 1.0f / sqrtf(s * (1.0f / 1024.0f) + 1e-6f);
#pragma unroll
                for (int bj = 0; bj < 2; ++bj)
#pragma unroll
                    for (int n = 0; n < 2; ++n) acc[ai][bj][m][n] = acc[ai][bj][m][n] * rs;
                if (m & 1) asm volatile("" ::: "memory"); }
        if (fr >= 14) {
#pragma unroll
            for (int ai = 0; ai < 2; ++ai) { const int blk = 2 * ai + wr;
#pragma unroll
                for (int bj = 0; bj < 2; ++bj)
#pragma unroll
                    for (int n = 0; n < 2; ++n) { const int col = bj * HALF + colt + 4 * n; const f32x4 v = acc[ai][bj][3][n];
                        *(PG8_LAS f32x4*)(ex + (blk * 2 + (fr - 14)) * 256 + col) = v;
                        if (blk == 3) { *(f32x4*)(UT + ((size_t)u.pm * 2 + (fr - 14)) * 5632 + u.pn * 256 + col) = v;
                            if ((u.pm & 7) == 7) *(f32x4*)(ffn_out + ((size_t)(u.pm >> 3) * 2 + (fr - 14)) * 5632 + bj * 2816 + u.pn * 128 + colt + 4 * n) = v; } } }
        }
        if (fr < 2 && wr == 0) {
#pragma unroll
            for (int bj = 0; bj < 2; ++bj)
#pragma unroll
                for (int n = 0; n < 2; ++n) *(f32x4*)(UH + ((size_t)u.pm * 2 + fr) * 5632 + u.pn * 256 + bj * HALF + colt + 4 * n) = acc[0][bj][0][n];
        }
        asm volatile("s_waitcnt lgkmcnt(0)" ::: "memory"); __builtin_amdgcn_s_barrier(); asm volatile("" ::: "memory");
#pragma unroll
        for (int ai = 0; ai < 2; ++ai) { const int blk = 2 * ai + wr;
#pragma unroll
            for (int n = 0; n < 2; ++n) { asm volatile("" ::: "memory");
#pragma unroll
                for (int bj = 0; bj < 2; ++bj) { const int col = bj * HALF + colt + 4 * n; const int nat = bj * 2816 + u.pn * 128 + colt + 4 * n;
                    const f32x4 w0 = *(const f32x4*)(cw + nat), w1 = *(const f32x4*)(cw + 5632 + nat), w2 = *(const f32x4*)(cw + 2 * 5632 + nat), bb = *(const f32x4*)(cb + nat);
                    f32x4 vprev = (f32x4){0.f, 0.f, 0.f, 0.f};
                    if (blk > 0 && fr >= 14) vprev = *(const PG8_LAS f32x4*)(ex + ((blk - 1) * 2 + (fr - 14)) * 256 + col);
#pragma unroll
                    for (int m = 3; m >= 0; --m) { const f32x4 cur = acc[ai][bj][m][n]; const f32x4 prv = (m > 0) ? acc[ai][bj][m - 1][n] : vprev; f32x4 o;
#pragma unroll
                        for (int e = 0; e < 4; ++e) { const float t1 = (fr == 15) ? prv[e] : cur[e], t2 = (fr >= 14) ? prv[e] : cur[e];
                            o[e] = bb[e] + w0[e] * dpp_ror2(t2) + w1[e] * dpp_ror1(t1) + w2[e] * cur[e]; }
                        acc[ai][bj][m][n] = o; } }
#pragma unroll
                for (int m = 0; m < 4; ++m) { const f32x4 g = acc[ai][0][m][n], v = acc[ai][1][m][n];
                    u32x2 w; w.x = cvt_pk_bf16(silu_f(g[0]) * v[0], silu_f(g[1]) * v[1]); w.y = cvt_pk_bf16(silu_f(g[2]) * v[2], silu_f(g[3]) * v[3]);
                    *(u32x2*)(H + (size_t)(row0 + ai * HALF + m * 16) * 2816 + u.pn * 128 + colt + 4 * n) = w; } } }
    }
};
template <class Epi, class Sched, bool ALIGN_EPI = false, bool SP2 = false>
__device__ __forceinline__ void gemm_phase(PG8_LAS unsigned char* lds, const Gemm g, const Sched& S, const Epi& E, const int tid) {
    const int wid = __builtin_amdgcn_readfirstlane(tid >> 6), lane = tid & 63, wr = wid >> 2, wc = wid & 3, fr = lane & 15, fq = lane >> 4;
    const int K = g.K, nt = K / BK;
    unsigned voffA[2], voffB[2];
#pragma unroll
    for (int i = 0; i < 2; ++i) { int R, C; stage_rc(tid * 16 + i * 8192, R, C); const int Rb = Epi::PERM ? ((R & ~31) + perm32(R & 31)) : R;
        voffA[i] = (unsigned)(R * K + C) * 2u; voffB[i] = (unsigned)(Rb * K + C) * 2u; }
    const size_t kstep = (size_t)(BK * 2);
    const size_t hstep = (size_t)HALF * K * 2;
    const size_t tstep = 2 * hstep;
    const unsigned ldsw = (unsigned)wid * 1024u;
    const int aoff = lds_byte(wr * 64 + fr, fq * 8), boff = lds_byte(wc * 32 + fr, fq * 8);
#define PG8_SA(b, h) (((b) * 2 + (h)) * HTB)
#define PG8_SB(b, h) ((4 + (b) * 2 + (h)) * HTB)
#define PG8_STAGE(bufoff, gbase, voff) do { _Pragma("unroll") for (int _i = 0; _i < 2; ++_i) \
        __builtin_amdgcn_global_load_lds((const unsigned*)((const char*)(gbase) + (voff)[_i]), (PG8_LAS unsigned*)(lds + (bufoff) + ldsw + _i * 8192), 16, 0, 0); } while (0)
#define PG8_LDA(dst, b, h) do { _Pragma("unroll") for (int m = 0; m < 4; ++m) _Pragma("unroll") for (int k = 0; k < 2; ++k) dst[m][k] = *(const PG8_LAS bf16x8*)(lds + PG8_SA(b, h) + aoff + m * 2048 + k * 1024); } while (0)
#define PG8_LDB(dst, b, h) do { _Pragma("unroll") for (int n = 0; n < 2; ++n) _Pragma("unroll") for (int k = 0; k < 2; ++k) dst[n][k] = *(const PG8_LAS bf16x8*)(lds + PG8_SB(b, h) + boff + n * 2048 + k * 1024); } while (0)
#define PG8_MMA(ai, bj, At, Bt) do { __builtin_amdgcn_s_setprio(1); _Pragma("unroll") for (int m = 0; m < 4; ++m) _Pragma("unroll") for (int n = 0; n < 2; ++n) _Pragma("unroll") for (int k = 0; k < 2; ++k) \
        acc[ai][bj][m][n] = __builtin_amdgcn_mfma_f32_16x16x32_bf16(Bt[n][k], At[m][k], acc[ai][bj][m][n], 0, 0, 0); __builtin_amdgcn_s_setprio(0); } while (0)
#define PG8_WAIT_V(n) asm volatile("s_waitcnt vmcnt(" #n ")" ::: "memory")
#define PG8_WAIT_L(n) asm volatile("s_waitcnt lgkmcnt(" #n ")" ::: "memory")
#define PG8_BAR __builtin_amdgcn_s_barrier()
#define PG8_SCHED __builtin_amdgcn_sched_barrier(0)
    Unit cur, nxt; int ui = 0;
    if (!S.next(0, cur)) return;
    f32x4 acc[2][2][4][2];
#pragma unroll
    for (int a = 0; a < 2; ++a)
#pragma unroll
        for (int b = 0; b < 2; ++b)
#pragma unroll
            for (int m = 0; m < 4; ++m)
#pragma unroll
                for (int n = 0; n < 2; ++n) acc[a][b][m][n] = (f32x4){0.f, 0.f, 0.f, 0.f};
    bf16x8 At[4][2], B0[2][2], B1[2][2];
    const char* cA = (const char*)g.A + (size_t)cur.pm * tstep; const char* cB = (const char*)g.Bt + (size_t)cur.pn * tstep;
    S.a_ready(cur);
    if constexpr (SP2) {
        PG8_STAGE(PG8_SB(0, 0), cB, voffB); PG8_STAGE(PG8_SB(0, 1), cB + hstep, voffB); PG8_STAGE(PG8_SA(0, 0), cA, voffA); PG8_STAGE(PG8_SA(0, 1), cA + hstep, voffA);
        if (wr == 1) PG8_BAR;
        PG8_WAIT_V(2); PG8_BAR;
        PG8_STAGE(PG8_SB(1, 0), cB + kstep, voffB); PG8_STAGE(PG8_SA(1, 0), cA + kstep, voffA); PG8_STAGE(PG8_SB(1, 1), cB + hstep + kstep, voffB);
        PG8_WAIT_V(6); PG8_BAR;
    } else {
        PG8_STAGE(PG8_SB(0, 0), cB, voffB); PG8_STAGE(PG8_SA(0, 0), cA, voffA); PG8_STAGE(PG8_SB(0, 1), cB + hstep, voffB); PG8_STAGE(PG8_SA(0, 1), cA + hstep, voffA);
        if (wr == 1) PG8_BAR;
        PG8_WAIT_V(4); PG8_BAR;
        PG8_STAGE(PG8_SB(1, 0), cB + kstep, voffB); PG8_STAGE(PG8_SA(1, 0), cA + kstep, voffA); PG8_STAGE(PG8_SB(1, 1), cB + hstep + kstep, voffB);
        PG8_WAIT_V(6); PG8_BAR;
    }
    for (;;) {
        const bool has_next = S.next(ui + 1, nxt);
        const char* nA = has_next ? (const char*)g.A + (size_t)nxt.pm * tstep : cA; const char* nB = has_next ? (const char*)g.Bt + (size_t)nxt.pn * tstep : cB;
        for (int t = 0; t < nt; t += 2) {
            const bool last = (t == nt - 2);
            const char* a1 = cA + (size_t)(t + 1) * kstep;
            const char* a2 = last ? nA : cA + (size_t)(t + 2) * kstep; const char* b2 = last ? nB : cB + (size_t)(t + 2) * kstep;
            const char* a3 = a2 + kstep; const char* b3 = b2 + kstep;
            if (last && has_next) S.a_ready(nxt);
            if constexpr (SP2) {
            PG8_LDB(B0, 0, 0); PG8_LDB(B1, 0, 1); PG8_SCHED; PG8_LDA(At, 0, 0); PG8_STAGE(PG8_SA(1, 1), a1 + hstep, voffA);
            PG8_WAIT_V(8); PG8_WAIT_L(0); PG8_BAR; PG8_MMA(0, 0, At, B0); PG8_MMA(0, 1, At, B1); PG8_BAR; PG8_SCHED;
            PG8_LDA(At, 0, 1); PG8_STAGE(PG8_SB(0, 0), b2, voffB); PG8_STAGE(PG8_SB(0, 1), b2 + hstep, voffB); PG8_STAGE(PG8_SA(0, 0), a2, voffA);
            PG8_WAIT_V(8); PG8_WAIT_L(0); PG8_BAR; PG8_MMA(1, 0, At, B0); PG8_MMA(1, 1, At, B1); PG8_BAR; PG8_SCHED;
            PG8_LDB(B0, 1, 0); PG8_LDB(B1, 1, 1); PG8_SCHED; PG8_LDA(At, 1, 0); PG8_STAGE(PG8_SA(0, 1), a2 + hstep, voffA);
            PG8_WAIT_V(8); PG8_WAIT_L(0); PG8_BAR; PG8_MMA(0, 0, At, B0); PG8_MMA(0, 1, At, B1); PG8_BAR; PG8_SCHED;
            PG8_LDA(At, 1, 1); PG8_STAGE(PG8_SB(1, 0), b3, voffB); PG8_STAGE(PG8_SB(1, 1), b3 + hstep, voffB); PG8_STAGE(PG8_SA(1, 0), a3, voffA);
            PG8_WAIT_V(8); PG8_WAIT_L(0); PG8_BAR; PG8_MMA(1, 0, At, B0); PG8_MMA(1, 1, At, B1); PG8_BAR; PG8_SCHED;
            } else {
            PG8_LDB(B0, 0, 0); PG8_SCHED; PG8_LDA(At, 0, 0); PG8_STAGE(PG8_SA(1, 1), a1 + hstep, voffA);
            PG8_WAIT_L(8); PG8_BAR; PG8_WAIT_L(0); PG8_MMA(0, 0, At, B0); PG8_BAR; PG8_SCHED;
            PG8_LDB(B1, 0, 1); PG8_STAGE(PG8_SB(0, 0), b2, voffB);
            PG8_BAR; PG8_WAIT_L(0); PG8_MMA(0, 1, At, B1); PG8_BAR;
            PG8_LDA(At, 0, 1); PG8_STAGE(PG8_SA(0, 0), a2, voffA);
            PG8_BAR; PG8_WAIT_L(0); PG8_MMA(1, 0, At, B0); PG8_BAR; PG8_SCHED;
            PG8_STAGE(PG8_SB(0, 1), b2 + hstep, voffB);
            PG8_WAIT_V(6); PG8_BAR; PG8_MMA(1, 1, At, B1); PG8_BAR;
            PG8_LDB(B0, 1, 0); PG8_SCHED; PG8_LDA(At, 1, 0); PG8_STAGE(PG8_SA(0, 1), a2 + hstep, voffA);
            PG8_WAIT_L(8); PG8_BAR; PG8_WAIT_L(0); PG8_MMA(0, 0, At, B0); PG8_BAR; PG8_SCHED;
            PG8_LDB(B1, 1, 1); PG8_STAGE(PG8_SB(1, 0), b3, voffB);
            PG8_BAR; PG8_WAIT_L(0); PG8_MMA(0, 1, At, B1); PG8_BAR;
            PG8_LDA(At, 1, 1); PG8_STAGE(PG8_SA(1, 0), a3, voffA);
            PG8_BAR; PG8_WAIT_L(0); PG8_MMA(1, 0, At, B0); PG8_BAR; PG8_SCHED;
            PG8_STAGE(PG8_SB(1, 1), b3 + hstep, voffB);
            PG8_WAIT_V(6); PG8_BAR; PG8_MMA(1, 1, At, B1); PG8_BAR;
            }
        }
        if constexpr (ALIGN_EPI) { if (wr == 0) PG8_BAR; }
        if constexpr (!Epi::AFTER_DRAIN) { E(acc, cur, wr, wc, fr, fq); S.done(cur); }
        if (!has_next) break;
#pragma unroll
        for (int a = 0; a < 2; ++a)
#pragma unroll
            for (int b = 0; b < 2; ++b)
#pragma unroll
                for (int m = 0; m < 4; ++m)
#pragma unroll
                    for (int n = 0; n < 2; ++n) acc[a][b][m][n] = (f32x4){0.f, 0.f, 0.f, 0.f};
        cur = nxt; cA = nA; cB = nB; ++ui;
        if constexpr (ALIGN_EPI) { if (wr == 1) PG8_BAR; }
    }
    PG8_WAIT_V(0);
    if constexpr (!ALIGN_EPI) { if (wr == 0) PG8_BAR; }
    PG8_BAR;
    if constexpr (Epi::AFTER_DRAIN) { E.fused(acc, cur, wr, wc, fr, fq, lds, wid, lane); S.done(cur); }
#undef PG8_SA
#undef PG8_SB
#undef PG8_STAGE
#undef PG8_LDA
#undef PG8_LDB
#undef PG8_MMA
#undef PG8_WAIT_V
#undef PG8_WAIT_L
#undef PG8_BAR
#undef PG8_SCHED
}
}

namespace mk {
constexpr int NWAVES = 8, NT = 512;
constexpr int DM = 1024, MP = 16384, NS = 128, SEQ = 2048, NB = 8;
constexpr int NPROJ = 4096, INC = 4120, UPN = 5632, DFF = 2816, DMIX = 2048, CONVD = 2048;
constexpr int NH = 24;
constexpr int PZ = 0, PX = 1536, PV = 3584;
constexpr float EPS = 1e-6f;
constexpr size_t O_YP = 0, O_YS = 16777216, O_SSMP = 16908288, O_SSMS = 17694720, O_CONVP = 30277632, O_CONVS = 30326784,
                 O_POOLP = 31113216, O_POOLS = 31174656, O_FFNP = 32157696, O_FFNS = 32247808, O_END = 33689600;
constexpr size_t KiB = 1024, MiB = 1048576;
constexpr size_t WS_CTL = 0, CTL_BYTES = 64 * KiB;
constexpr size_t WS_WIN = 64 * KiB;
constexpr size_t WS_WOUT = WS_WIN + 8 * MiB;
constexpr size_t WS_WUP = WS_WOUT + 4 * MiB;
constexpr size_t WS_WDN = WS_WUP + 11 * MiB;
constexpr size_t WS_WDT = WS_WDN + 5632 * KiB;
constexpr size_t WS_PWT = WS_WDT + 64 * KiB;
constexpr size_t WS_A = WS_PWT + 128 * KiB;
constexpr size_t WS_B = WS_A + 32 * MiB;
constexpr size_t WS_Y = WS_B + 128 * MiB;
constexpr size_t WS_DT = WS_Y + 64 * MiB;
constexpr size_t WS_CDEC = WS_DT + 1536 * KiB;
constexpr size_t WS_X1S = WS_CDEC + 16 * KiB;
constexpr size_t WS_XN2S = WS_X1S + 512 * KiB;
constexpr size_t WS_XN1S = WS_XN2S + 256 * KiB;
constexpr size_t WS_FCW = WS_XN1S + 256 * KiB;
constexpr size_t WS_END = WS_FCW + 128 * KiB;
static_assert(WS_END <= 256 * MiB, "workspace map");
constexpr size_t WB_H = 0, WB_UT = 88 * MiB, WB_UH = 91 * MiB, WB_SSP = 94 * MiB, WB_SSP2 = 95 * MiB, WB_HS = 96 * MiB, WB_X2S = 97 * MiB;
constexpr size_t OS_PROJS = O_FFNS, OS_DTS = O_FFNS + 128 * 4096, OS_YS = OS_DTS + 128 * 32;
static_assert(OS_YS + 131072 <= O_END, "sample scratch");
constexpr int LDS_BYTES = 163840, RING_OFF = 0, EX_OFF = 131072, MISC_OFF = LDS_BYTES - 512;
constexpr int CW_BAR = 4096;

#define LAS __attribute__((address_space(3)))
typedef unsigned short bf16;
typedef unsigned v4u __attribute__((ext_vector_type(4)));
typedef unsigned v2u __attribute__((ext_vector_type(2)));
typedef float f32x4 __attribute__((ext_vector_type(4)));
typedef short bf16x8 __attribute__((ext_vector_type(8)));
typedef short s16x4 __attribute__((ext_vector_type(4)));
#define LDS_WAIT() asm volatile("s_waitcnt lgkmcnt(0)" ::: "memory")
#define VM_WAIT() asm volatile("s_waitcnt vmcnt(0)" ::: "memory")
using pg8::cvt_pk_bf16; using pg8::silu_f;
__device__ __forceinline__ float bf2f(short h) { return __uint_as_float(((unsigned)(unsigned short)h) << 16); }
__device__ __forceinline__ unsigned short f2bf(float f) { return (unsigned short)(cvt_pk_bf16(f, 0.f) & 0xffffu); }
__device__ __forceinline__ float softplus_f(float x) { return x > 20.f ? x : log1pf(__expf(x)); }
__device__ __forceinline__ float wave_sum(float v) {
#pragma unroll
    for (int o = 1; o < 64; o <<= 1) v += __shfl_xor(v, o);
    return v;
}
__device__ __forceinline__ bf16x8 cat8(s16x4 lo, s16x4 hi) { bf16x8 r; r[0] = lo[0]; r[1] = lo[1]; r[2] = lo[2]; r[3] = lo[3]; r[4] = hi[0]; r[5] = hi[1]; r[6] = hi[2]; r[7] = hi[3]; return r; }
__device__ __forceinline__ s16x4 tr_read(const LAS bf16* p) { return __builtin_amdgcn_ds_read_tr16_b64_v4i16((LAS s16x4*)p); }
__device__ __forceinline__ int lane_now() { int t; asm volatile("v_mbcnt_lo_u32_b32 %0, -1, 0\n\tv_mbcnt_hi_u32_b32 %0, -1, %0" : "=v"(t)); return t; }
#define MFMA16(a, b, c) __builtin_amdgcn_mfma_f32_16x16x32_bf16((a), (b), (c), 0, 0, 0)
__device__ __forceinline__ const float* arg_in(int k) { const char* p = (const char*)__builtin_amdgcn_kernarg_segment_ptr(); asm volatile("" : "+s"(p)); return *(const float* const*)(p + 8 * k); }
#define x_prompt (arg_in(0))
#define x_sample (arg_in(1))
#define state_ssm (arg_in(2))
#define state_conv (arg_in(3))
#define state_pool (arg_in(4))
#define state_ffn (arg_in(5))
#define norm1_w (arg_in(6))
#define w_in (arg_in(7))
#define conv_w (arg_in(8))
#define conv_b (arg_in(9))
#define dt_bias (arg_in(10))
#define a_log (arg_in(11))
#define d_skip (arg_in(12))
#define ssd_norm_w (arg_in(13))
#define pool_w (arg_in(14))
#define pool_scale (arg_in(15))
#define w_out (arg_in(16))
#define norm2_w (arg_in(17))
#define w_up (arg_in(18))
#define ffn_conv_w (arg_in(19))
#define ffn_conv_b (arg_in(20))
#define w_down (arg_in(21))
#define final_norm_w (arg_in(22))

#define XB_TMO      128
#define XB_XCNT(j)  (256  + 64 * (j))
#define XB_XSUB(j)  (1280 + 64 * (j))
#define XB_XGEN(j)  (2304 + 64 * (j))
#define XB_TOP      3328
#define XB_TOPGEN   3392
#define XCD_BAR_WORDS 3456
#define XB_SPIN_CAP (1u << 18)

__device__ __forceinline__ unsigned xb_ld(unsigned* p)              { return __hip_atomic_load(p, __ATOMIC_RELAXED, __HIP_MEMORY_SCOPE_AGENT); }
__device__ __forceinline__ unsigned xb_add(unsigned* p, unsigned v) { return __hip_atomic_fetch_add(p, v, __ATOMIC_RELAXED, __HIP_MEMORY_SCOPE_AGENT); }
__device__ __forceinline__ unsigned xb_xcc_id() { return (unsigned)__builtin_amdgcn_s_getreg((3 << 11) | 20) & 0xFu; }
#define XB_SPIN(cond, bar) do { unsigned _sp = 0; while (cond) { __builtin_amdgcn_s_sleep(1); \
    if ((++_sp & 255u) == 0u) { if (xb_ld(&(bar)[XB_TMO])) break; if (_sp > XB_SPIN_CAP) { atomicAdd(&(bar)[XB_TMO], 1u); break; } } } } while (0)

struct XcdBarrier {
    unsigned* bar; unsigned x;
    volatile LAS unsigned* st;
};

__device__ __forceinline__ XcdBarrier xcd_barrier_post(unsigned* bar, volatile LAS unsigned* st, const bool t0) {
    XcdBarrier b; b.bar = bar; b.x = xb_xcc_id(); b.st = st;
    if (t0) (void)xb_add(&bar[XB_XCNT(b.x)], 1u);
    return b;
}
__device__ __forceinline__ void xcd_barrier_complete(unsigned* bar, unsigned x, unsigned& nloc, unsigned& nx) {
    const unsigned G = gridDim.x * gridDim.y * gridDim.z;
    unsigned sum, cnt, mine, sp = 0u;
    for (;;) {
        sum = 0u; cnt = 0u; mine = 0u;
#pragma unroll
        for (unsigned j = 0; j < 16; ++j) { const unsigned c = xb_ld(&bar[XB_XCNT(j)]); sum += c; cnt += (c > 0u) ? 1u : 0u; mine = (j == x) ? c : mine; }
        if (sum == G) break;
        __builtin_amdgcn_s_sleep(1);
        if ((++sp & 255u) == 0u) { if (xb_ld(&bar[XB_TMO])) break; if (sp > XB_SPIN_CAP) { atomicAdd(&bar[XB_TMO], 1u); break; } }
    }
    nloc = mine > 0u ? mine : 1u; nx = cnt > 0u ? cnt : 1u;
}

__device__ __forceinline__ void xcd_barrier(const XcdBarrier& b, const bool t0) {
    asm volatile("s_waitcnt vmcnt(0)" ::: "memory");
    __syncthreads();
    if (t0) {
        unsigned* bar = b.bar;
        __builtin_amdgcn_s_waitcnt(0);
        unsigned nloc = b.st[0], nx = b.st[1];
        if (nloc == 0u) { xcd_barrier_complete(bar, b.x, nloc, nx); b.st[0] = nloc; b.st[1] = nx; }
        const unsigned old = xb_add(&bar[XB_XSUB(b.x)], 1u);
        const unsigned gen = old / nloc;
        if (old + 1u == (gen + 1u) * nloc) {
            __builtin_amdgcn_fence(__ATOMIC_RELEASE, "agent");
            asm volatile("s_waitcnt vmcnt(0)" ::: "memory");
            const unsigned og = xb_add(&bar[XB_TOP], 1u);
            const unsigned tg = og / nx;
            if (og + 1u == (tg + 1u) * nx) xb_add(&bar[XB_TOPGEN], 1u);
            else XB_SPIN(xb_ld(&bar[XB_TOPGEN]) == tg, bar);
            __builtin_amdgcn_fence(__ATOMIC_ACQUIRE, "agent");
            xb_add(&bar[XB_XGEN(b.x)], 1u);
            asm volatile("s_waitcnt vmcnt(0)" ::: "memory");
        } else {
            XB_SPIN(xb_ld(&bar[XB_XGEN(b.x)]) == gen, bar);
            __builtin_amdgcn_fence(__ATOMIC_ACQUIRE, "agent");
            asm volatile("s_waitcnt vmcnt(0)" ::: "memory");
        }
    }
    __syncthreads();
}

struct Ctx { LAS unsigned char* lds; int tid, lane, wave, vcu, G; };

__device__ __forceinline__ void transpose_item(const float* W, int ldw, int k0, int ns0, int nvalid, bf16* WT, int K, int drow0, const float* fold, LAS float* scr, int lane) {
#pragma unroll 8
    for (int i = 0; i < 32; ++i) { const int kk = 2 * i + (lane >> 5), nn = lane & 31;
        float v = (nn < nvalid) ? W[(size_t)(k0 + kk) * ldw + ns0 + nn] : 0.f;
        if (fold) v *= fold[k0 + kk];
        scr[kk * 33 + nn] = v; }
    LDS_WAIT(); asm volatile("" ::: "memory");
    const int c = lane & 7;
#pragma unroll
    for (int j = 0; j < 4; ++j) { const int n = (lane >> 3) + 8 * j; const LAS float* s = scr + (8 * c) * 33 + n;
        v4u o; o.x = cvt_pk_bf16(s[0 * 33], s[1 * 33]); o.y = cvt_pk_bf16(s[2 * 33], s[3 * 33]); o.z = cvt_pk_bf16(s[4 * 33], s[5 * 33]); o.w = cvt_pk_bf16(s[6 * 33], s[7 * 33]);
        *(v4u*)(WT + (size_t)(drow0 + n) * K + k0 + 8 * c) = o; }
    LDS_WAIT(); asm volatile("" ::: "memory");
}
__device__ __forceinline__ void rms_row_to_bf16(const float* xrow, const float* w, bf16* orow, int lane) {
    const f32x4* xr = (const f32x4*)xrow + lane;
    f32x4 v[4]; float s = 0.f;
#pragma unroll
    for (int j = 0; j < 4; ++j) { v[j] = xr[64 * j]; s += (v[j][0] * v[j][0] + v[j][1] * v[j][1]) + (v[j][2] * v[j][2] + v[j][3] * v[j][3]); }
    const float rs = 1.0f / sqrtf(wave_sum(s) * (1.0f / 1024.0f) + EPS);
    v2u* o8 = (v2u*)orow + lane;
#pragma unroll
    for (int j = 0; j < 4; ++j) { f32x4 ww = (f32x4){1.f, 1.f, 1.f, 1.f}; if (w) ww = ((const f32x4*)w)[lane + 64 * j];
        v2u o; o.x = cvt_pk_bf16(v[j][0] * rs * ww[0], v[j][1] * rs * ww[1]); o.y = cvt_pk_bf16(v[j][2] * rs * ww[2], v[j][3] * rs * ww[3]); o8[64 * j] = o; }
}

template <int R16, int K> __device__ __forceinline__ void skinny_acc(const bf16* A, const bf16* Wt, int row0, int n0, int wave, int lane, f32x4 (&acc)[R16]) {
    constexpr int KW = K / 8, NS_ = KW / 32;
    static_assert(KW % 32 == 0, "K split");
    const bf16* ap = A + (size_t)(row0 + (lane & 15)) * K + wave * KW + 8 * (lane >> 4);
    const bf16* bp = Wt + (size_t)(n0 + (lane & 15)) * K + wave * KW + 8 * (lane >> 4);
#pragma unroll
    for (int mi = 0; mi < R16; ++mi) acc[mi] = (f32x4){0.f, 0.f, 0.f, 0.f};
#pragma unroll
    for (int ks = 0; ks < NS_; ++ks) { const bf16x8 b = *(const bf16x8*)(bp + 32 * ks);
#pragma unroll
        for (int mi = 0; mi < R16; ++mi) { const bf16x8 a = *(const bf16x8*)(ap + (size_t)mi * 16 * K + 32 * ks); acc[mi] = MFMA16(a, b, acc[mi]); } }
}
template <int R16> __device__ __forceinline__ f32x4 skinny_reduce(LAS float* red, const f32x4 (&acc)[R16], int wave, int lane, int tid) {
#pragma unroll
    for (int mi = 0; mi < R16; ++mi) *(LAS f32x4*)(red + ((wave * R16 + mi) * 64 + lane) * 4) = acc[mi];
    __syncthreads();
    f32x4 s = (f32x4){0.f, 0.f, 0.f, 0.f};
    if ((tid >> 6) < R16) {
#pragma unroll
        for (int w = 0; w < 8; ++w) s += *(const LAS f32x4*)(red + ((w * R16 + (tid >> 6)) * 64 + (tid & 63)) * 4);
    }
    __syncthreads();
    return s;
}

constexpr int XS = 392, BS = 72;
constexpr int S_XS = 0, S_BS = 128 * XS * 2, S_CS = S_BS + 128 * BS * 2, S_AC = S_CS + 128 * BS * 2, S_DT = S_AC + 6 * 128 * 4, S_WV = S_DT + 6 * 128 * 4, S_END = S_WV + 6 * 128 * 4;
static_assert(S_END <= MISC_OFF, "S-phase LDS map");
template <bool WITH_C> __device__ __forceinline__ void conv_stage(const Ctx& F, const bf16* PROJ, int b, int c, int g, float* conv_out) {
    const int cg = F.tid & 63, rs = F.tid >> 6;
    int ch; LAS bf16* dst; int dstride;
    if (cg < 48) { ch = 384 * g + 8 * cg; dst = (LAS bf16*)(F.lds + S_XS) + 8 * cg; dstride = XS; }
    else if (cg < 56) { ch = 1536 + 64 * g + 8 * (cg - 48); dst = (LAS bf16*)(F.lds + S_BS) + 8 * (cg - 48); dstride = BS; }
    else { ch = 1792 + 64 * g + 8 * (cg - 56); dst = (LAS bf16*)(F.lds + S_CS) + 8 * (cg - 56); dstride = BS; }
    if (!WITH_C && cg >= 56) return;
    float w[4][8], bias[8];
#pragma unroll
    for (int k = 0; k < 4; ++k) { const f32x4 a = *(const f32x4*)(conv_w + k * CONVD + ch), d = *(const f32x4*)(conv_w + k * CONVD + ch + 4);
        w[k][0] = a[0]; w[k][1] = a[1]; w[k][2] = a[2]; w[k][3] = a[3]; w[k][4] = d[0]; w[k][5] = d[1]; w[k][6] = d[2]; w[k][7] = d[3]; }
    { const f32x4 a = *(const f32x4*)(conv_b + ch), d = *(const f32x4*)(conv_b + ch + 4);
        bias[0] = a[0]; bias[1] = a[1]; bias[2] = a[2]; bias[3] = a[3]; bias[4] = d[0]; bias[5] = d[1]; bias[6] = d[2]; bias[7] = d[3]; }
    const bf16* src = PROJ + ((size_t)b * SEQ + c * 128 + 16 * rs) * NPROJ + PX + ch;
    float r0[8], r1[8], r2[8];
    const bool zero_hist = (c == 0 && rs == 0);
    { bf16x8 h0 = {0,0,0,0,0,0,0,0}, h1 = h0, h2 = h0;
      if (!zero_hist) { h0 = *(const bf16x8*)(src - 3 * NPROJ); h1 = *(const bf16x8*)(src - 2 * NPROJ); h2 = *(const bf16x8*)(src - 1 * NPROJ); }
#pragma unroll
      for (int j = 0; j < 8; ++j) { r0[j] = bf2f(h0[j]); r1[j] = bf2f(h1[j]); r2[j] = bf2f(h2[j]); } }
#pragma unroll 4
    for (int i = 0; i < 16; ++i) { const int l = 16 * rs + i;
        const bf16x8 raw = *(const bf16x8*)(src + (size_t)i * NPROJ);
        float cur[8], o[8];
#pragma unroll
        for (int j = 0; j < 8; ++j) { cur[j] = bf2f(raw[j]); o[j] = silu_f(bias[j] + w[0][j] * r0[j] + w[1][j] * r1[j] + w[2][j] * r2[j] + w[3][j] * cur[j]); }
        v4u pk; pk.x = cvt_pk_bf16(o[0], o[1]); pk.y = cvt_pk_bf16(o[2], o[3]); pk.z = cvt_pk_bf16(o[4], o[5]); pk.w = cvt_pk_bf16(o[6], o[7]);
        *(LAS v4u*)(dst + l * dstride) = pk;
        if (conv_out && l >= 125) { float* op = conv_out + (size_t)(l - 125) * CONVD + ch;
            *(f32x4*)op = (f32x4){cur[0], cur[1], cur[2], cur[3]}; *(f32x4*)(op + 4) = (f32x4){cur[4], cur[5], cur[6], cur[7]}; }
#pragma unroll
        for (int j = 0; j < 8; ++j) { r0[j] = r1[j]; r1[j] = r2[j]; r2[j] = cur[j]; } }
}
__device__ __forceinline__ void dt_stage(const Ctx& F, const float* DT, int b, int c, int g, float* cdec_out) {
    if (F.wave < 6) { const int hh = 6 * g + F.wave; const float a = -__expf(a_log[hh]);
        const size_t row = (size_t)b * SEQ + c * 128 + 2 * F.lane;
        const float d0 = DT[row * 24 + hh], d1 = DT[(row + 1) * 24 + hh];
        const float v0 = d0 * a, v1 = d1 * a; float s = v0 + v1;
#pragma unroll
        for (int o = 1; o < 64; o <<= 1) { const float t = __shfl_up(s, o); if (F.lane >= o) s += t; }
        const float tot = __shfl(s, 63);
        LAS float* ac = (LAS float*)(F.lds + S_AC) + F.wave * 128 + 2 * F.lane;
        LAS float* dl = (LAS float*)(F.lds + S_DT) + F.wave * 128 + 2 * F.lane;
        LAS float* wv = (LAS float*)(F.lds + S_WV) + F.wave * 128 + 2 * F.lane;
        const float a0 = s - v1, a1 = s;
        ac[0] = a0; ac[1] = a1; dl[0] = d0; dl[1] = d1; wv[0] = __expf(tot - a0) * d0; wv[1] = __expf(tot - a1) * d1;
        if (cdec_out && F.lane == 0) cdec_out[hh] = __expf(tot); }
}

__device__ __forceinline__ void s1_unit(const Ctx& F, const bf16* PROJ, const float* DT, float* CS, float* CDEC, float* conv_prompt, int unit) {
    const int g = unit & 3, c = (unit >> 2) & 15, b = unit >> 6;
    conv_stage<true>(F, PROJ, b, c, g, (c == 15) ? conv_prompt + (size_t)b * 3 * CONVD : nullptr);
    dt_stage(F, DT, b, c, g, CDEC + (b * 16 + c) * 24);
    __syncthreads();
    const int i = F.lane & 15, g4 = F.lane >> 4;
    const LAS bf16* xs = (const LAS bf16*)(F.lds + S_XS); const LAS bf16* Bs = (const LAS bf16*)(F.lds + S_BS); const LAS float* wv = (const LAS float*)(F.lds + S_WV);
    bf16x8 Bf[4][4];
#pragma unroll
    for (int nt = 0; nt < 4; ++nt)
#pragma unroll
        for (int ks = 0; ks < 4; ++ks) { const LAS bf16* p = Bs + (32 * ks + 4 * g4 + (i >> 2)) * BS + 16 * nt + 4 * (i & 3); Bf[nt][ks] = cat8(tr_read(p), tr_read(p + 16 * BS)); }
#pragma unroll 1
    for (int pr = 0; pr < 3; ++pr) { const int pair = F.wave * 3 + pr, h = pair >> 2, pt = pair & 3;
        bf16x8 Af[4];
#pragma unroll
        for (int ks = 0; ks < 4; ++ks) { const LAS bf16* p = xs + (32 * ks + 4 * g4 + (i >> 2)) * XS + 64 * h + 16 * pt + 4 * (i & 3);
            const s16x4 lo = tr_read(p), hi = tr_read(p + 16 * XS);
            const f32x4 w0 = *(const LAS f32x4*)(wv + h * 128 + 32 * ks + 4 * g4), w1 = *(const LAS f32x4*)(wv + h * 128 + 32 * ks + 16 + 4 * g4);
            v4u pk; pk.x = cvt_pk_bf16(bf2f(lo[0]) * w0[0], bf2f(lo[1]) * w0[1]); pk.y = cvt_pk_bf16(bf2f(lo[2]) * w0[2], bf2f(lo[3]) * w0[3]);
            pk.z = cvt_pk_bf16(bf2f(hi[0]) * w1[0], bf2f(hi[1]) * w1[1]); pk.w = cvt_pk_bf16(bf2f(hi[2]) * w1[2], bf2f(hi[3]) * w1[3]);
            Af[ks] = __builtin_bit_cast(bf16x8, pk); }
        f32x4 acc[4];
#pragma unroll
        for (int nt = 0; nt < 4; ++nt) { acc[nt] = (f32x4){0.f, 0.f, 0.f, 0.f};
#pragma unroll
            for (int ks = 0; ks < 4; ++ks) acc[nt] = MFMA16(Bf[nt][ks], Af[ks], acc[nt]); }
        float* o = CS + ((((size_t)b * 16 + c) * 24 + 6 * g + h) * 64 + 16 * pt + i) * 64 + 4 * g4;
#pragma unroll
        for (int nt = 0; nt < 4; ++nt) *(f32x4*)(o + 16 * nt) = acc[nt]; }
    __syncthreads();
}

constexpr int VS = 136;
constexpr int PL_V = 0, PL_M = 143 * VS * 2;
__device__ __forceinline__ void pool_unit(const Ctx& F, const bf16* PROJ, const bf16* PWt, bf16* Y, float* pool_prompt, int unit) {
    const int g = unit & 3, tt = unit >> 2, b = tt >> 4, t0 = (tt & 15) * 128;
    LAS bf16* vs = (LAS bf16*)(F.lds + PL_V); LAS bf16* ms = (LAS bf16*)(F.lds + PL_M);
    for (int it = F.tid; it < 143 * 16; it += NT) { const int r = it >> 4, cgp = it & 15; const int t = t0 - 15 + r;
        v4u v = (v4u){0u, 0u, 0u, 0u};
        if (t >= 0) v = *(const v4u*)(PROJ + ((size_t)b * SEQ + t) * NPROJ + PV + 128 * g + 8 * cgp);
        *(LAS v4u*)(vs + r * VS + 8 * cgp) = v; }
    __syncthreads();
    const int w = 2 << g;
    for (int it = F.tid; it < 128 * 16; it += NT) { const int l = it >> 4, cgp = it & 15;
        float s[8] = {0.f, 0.f, 0.f, 0.f, 0.f, 0.f, 0.f, 0.f}; bf16x8 cur;
        for (int j = 0; j < w; ++j) { cur = *(const LAS bf16x8*)(vs + (l + 15 - (w - 1) + j) * VS + 8 * cgp);
#pragma unroll
            for (int e = 0; e < 8; ++e) s[e] += bf2f(cur[e]); }
        const int cnt = (t0 + l + 1 < w) ? (t0 + l + 1) : w; const float inv = 1.0f / (float)cnt;
        float o[8];
#pragma unroll
        for (int e = 0; e < 8; ++e) o[e] = s[e] * inv - bf2f(cur[e]);
        v4u pk; pk.x = cvt_pk_bf16(o[0], o[1]); pk.y = cvt_pk_bf16(o[2], o[3]); pk.z = cvt_pk_bf16(o[4], o[5]); pk.w = cvt_pk_bf16(o[6], o[7]);
        *(LAS v4u*)(ms + l * VS + 8 * cgp) = pk; }
    if ((tt & 15) == 15) {
        for (int it = F.tid; it < 15 * 128; it += NT) { const int r = it >> 7, cc = it & 127;
            pool_prompt[((size_t)b * 15 + r) * 512 + 128 * g + cc] = bf2f((short)vs[(128 + r) * VS + cc]); } }
    __syncthreads();
    const int i = F.lane & 15, g4 = F.lane >> 4;
    bf16x8 Af[4];
#pragma unroll
    for (int ks = 0; ks < 4; ++ks) Af[ks] = *(const LAS bf16x8*)(ms + (16 * F.wave + i) * VS + 32 * ks + 8 * g4);
    const size_t row = (size_t)b * SEQ + t0 + 16 * F.wave + i;
#pragma unroll
    for (int nt = 0; nt < 8; ++nt) { f32x4 acc = (f32x4){0.f, 0.f, 0.f, 0.f};
#pragma unroll
        for (int ks = 0; ks < 4; ++ks) { const bf16x8 bfr = *(const bf16x8*)(PWt + ((size_t)g * 128 + 16 * nt + i) * 128 + 32 * ks + 8 * g4); acc = MFMA16(bfr, Af[ks], acc); }
        const f32x4 sc = *(const f32x4*)(pool_scale + 128 * g + 16 * nt + 4 * g4);
        v2u pk; pk.x = cvt_pk_bf16(acc[0] * sc[0], acc[1] * sc[1]); pk.y = cvt_pk_bf16(acc[2] * sc[2], acc[3] * sc[3]);
        *(v2u*)(Y + row * DMIX + 1536 + 128 * g + 16 * nt + 4 * g4) = pk; }
    __syncthreads();
}

__device__ __forceinline__ void ssm_sample_unit(const Ctx& F, float* out, int unit) {
    const float* PROJS = out + OS_PROJS; const float* DTS = out + OS_DTS; bf16* YS = (bf16*)(out + OS_YS); float* ssm_out = out + O_SSMS; float* conv_out = out + O_CONVS;
    const int g = unit & 3, b = unit >> 2, tid = F.tid;
    LAS float* sx = (LAS float*)F.lds;
    LAS float* sy = sx + 512;
    LAS float* sred = sy + 384;
    const int p = tid >> 3, ng = tid & 7;
    f32x4 h0[6][2];
#pragma unroll
    for (int h = 0; h < 6; ++h) { const float* sp = state_ssm + ((((size_t)b * NH + 6 * g + h) * 64 + p) * 64 + 8 * ng); h0[h][0] = *(const f32x4*)sp; h0[h][1] = *(const f32x4*)(sp + 4); }
    { const int ch = (tid < 384) ? 384 * g + tid : (tid < 448 ? 1536 + 64 * g + (tid - 384) : 1792 + 64 * g + (tid - 448));
      const float* st = state_conv + (size_t)b * 3 * CONVD + ch; const float s0 = st[0], s1 = st[CONVD], s2 = st[2 * CONVD], nw = PROJS[(size_t)b * NPROJ + PX + ch];
      sx[tid] = silu_f(conv_b[ch] + conv_w[ch] * s0 + conv_w[CONVD + ch] * s1 + conv_w[2 * CONVD + ch] * s2 + conv_w[3 * CONVD + ch] * nw);
      float* co = conv_out + (size_t)b * 3 * CONVD + ch; co[0] = s1; co[CONVD] = s2; co[2 * CONVD] = nw; }
    __syncthreads();
    float bn[8], cn[8];
#pragma unroll
    for (int j = 0; j < 8; ++j) { bn[j] = sx[384 + 8 * ng + j]; cn[j] = sx[448 + 8 * ng + j]; }
    float ssq = 0.f;
#pragma unroll
    for (int h = 0; h < 6; ++h) { const int hh = 6 * g + h; const float dt = DTS[b * 24 + hh], dA = __expf(-dt * __expf(a_log[hh])); const float xp = sx[64 * h + p], dx = dt * xp;
        f32x4 n0, n1; float yp = 0.f;
#pragma unroll
        for (int j = 0; j < 4; ++j) { n0[j] = dA * h0[h][0][j] + dx * bn[j]; n1[j] = dA * h0[h][1][j] + dx * bn[4 + j]; yp += cn[j] * n0[j] + cn[4 + j] * n1[j]; }
        float* op = ssm_out + ((((size_t)b * NH + hh) * 64 + p) * 64 + 8 * ng); *(f32x4*)op = n0; *(f32x4*)(op + 4) = n1;
        yp += __shfl_xor(yp, 1); yp += __shfl_xor(yp, 2); yp += __shfl_xor(yp, 4);
        const float y = (yp + d_skip[hh] * xp) * silu_f(PROJS[(size_t)b * NPROJ + PZ + 64 * hh + p]);
        if (ng == 0) { sy[64 * h + p] = y; ssq += y * y; } }
    ssq = wave_sum(ssq);
    if (F.lane == 0) sred[F.wave] = ssq;
    __syncthreads();
    float tot = 0.f;
#pragma unroll
    for (int w = 0; w < 8; ++w) tot += sred[w];
    const float rs = 1.0f / sqrtf(tot * (1.0f / 384.0f) + EPS);
    if (tid < 384) YS[(size_t)b * DMIX + 384 * g + tid] = f2bf(sy[tid] * rs * ssd_norm_w[384 * g + tid]);
    __syncthreads();
}
__device__ __forceinline__ void pool_sample_unit(const Ctx& F, float* out, int b) {
    const float* PROJS = out + OS_PROJS; bf16* YS = (bf16*)(out + OS_YS); float* pool_out = out + O_POOLS;
    LAS float* sm = (LAS float*)F.lds; const int tid = F.tid, g = F.wave >> 1, w = 2 << g;
    const float vn = PROJS[(size_t)b * NPROJ + PV + tid]; const float* sp = state_pool + (size_t)b * 15 * 512 + tid; float* po = pool_out + (size_t)b * 15 * 512 + tid;
    float s = vn;
#pragma unroll
    for (int r = 0; r < 15; ++r) { const float v = sp[r * 512]; if (r >= 15 - (w - 1)) s += v; if (r >= 1) po[(r - 1) * 512] = v; }
    po[14 * 512] = vn;
    sm[tid] = s * (1.0f / (float)w) - vn;
    __syncthreads();
    const int d = tid & 127; const float* pw = pool_w + (size_t)g * 16384 + d; float acc = 0.f;
#pragma unroll 8
    for (int c = 0; c < 128; ++c) acc += sm[128 * g + c] * pw[c * 128];
    YS[(size_t)b * DMIX + 1536 + tid] = f2bf(acc * pool_scale[tid]);
    __syncthreads();
}

__device__ __forceinline__ void s3_unit(const Ctx& F, const bf16* PROJ, const float* DT, const bf16* HIN, bf16* Y, int unit) {
    const int g = unit & 3, c = (unit >> 2) & 15, b = unit >> 6;
    conv_stage<true>(F, PROJ, b, c, g, nullptr);
    dt_stage(F, DT, b, c, g, nullptr);
    __syncthreads();
    const int i = F.lane & 15, g4 = F.lane >> 4, w = F.wave, lrow = 16 * w + i;
    const LAS bf16* xs = (const LAS bf16*)(F.lds + S_XS); const LAS bf16* Bs = (const LAS bf16*)(F.lds + S_BS); const LAS bf16* Cs = (const LAS bf16*)(F.lds + S_CS);
    const LAS float* acs = (const LAS float*)(F.lds + S_AC); const LAS float* dts = (const LAS float*)(F.lds + S_DT);
    bf16x8 Cf[2];
#pragma unroll
    for (int ks = 0; ks < 2; ++ks) Cf[ks] = *(const LAS bf16x8*)(Cs + lrow * BS + 32 * ks + 8 * g4);
    f32x4 X[8];
#pragma unroll
    for (int st = 0; st < 8; ++st) { X[st] = (f32x4){0.f, 0.f, 0.f, 0.f};
        if (st <= w) {
#pragma unroll
            for (int ks = 0; ks < 2; ++ks) { const bf16x8 a = *(const LAS bf16x8*)(Bs + (16 * st + i) * BS + 32 * ks + 8 * g4); X[st] = MFMA16(a, Cf[ks], X[st]); } } }
    const size_t grow = (size_t)b * SEQ + c * 128 + lrow;
    float mk[4], dg[4];
#pragma unroll
    for (int r = 0; r < 4; ++r) { mk[r] = (4 * g4 + r <= i) ? 1.f : 0.f; dg[r] = (4 * g4 + r == i) ? 1.f : 0.f; }
    float ssq = 0.f;
#pragma unroll 1
    for (int h = 0; h < 6; ++h) { const int hh = 6 * g + h; const float al = acs[h * 128 + lrow], Dh = d_skip[hh];
        f32x4 ya[4], yo[4];
#pragma unroll
        for (int pt = 0; pt < 4; ++pt) { ya[pt] = (f32x4){0.f, 0.f, 0.f, 0.f}; yo[pt] = (f32x4){0.f, 0.f, 0.f, 0.f}; }
#pragma unroll
        for (int u = 0; u < 4; ++u) { if (2 * u <= w) {
            float mv[8];
#pragma unroll
            for (int hf = 0; hf < 2; ++hf) { const int st = 2 * u + hf;
                if (st < w) { const f32x4 as4 = *(const LAS f32x4*)(acs + h * 128 + 16 * st + 4 * g4), dt4 = *(const LAS f32x4*)(dts + h * 128 + 16 * st + 4 * g4);
#pragma unroll
                    for (int r = 0; r < 4; ++r) mv[4 * hf + r] = X[st][r] * __expf(al - as4[r]) * dt4[r]; }
                else if (st == w) { const f32x4 as4 = *(const LAS f32x4*)(acs + h * 128 + 16 * st + 4 * g4), dt4 = *(const LAS f32x4*)(dts + h * 128 + 16 * st + 4 * g4);
#pragma unroll
                    for (int r = 0; r < 4; ++r) mv[4 * hf + r] = X[st][r] * __expf(fminf(al - as4[r], 0.f)) * dt4[r] * mk[r] + Dh * dg[r]; }
                else {
#pragma unroll
                    for (int r = 0; r < 4; ++r) mv[4 * hf + r] = 0.f; } }
            v4u pk; pk.x = cvt_pk_bf16(mv[0], mv[1]); pk.y = cvt_pk_bf16(mv[2], mv[3]); pk.z = cvt_pk_bf16(mv[4], mv[5]); pk.w = cvt_pk_bf16(mv[6], mv[7]);
            const bf16x8 mf = __builtin_bit_cast(bf16x8, pk);
#pragma unroll
            for (int pt = 0; pt < 4; ++pt) { const LAS bf16* p = xs + (32 * u + 4 * g4 + (i >> 2)) * XS + 64 * h + 16 * pt + 4 * (i & 3);
                const bf16x8 xf = cat8(tr_read(p), tr_read(p + 16 * XS)); ya[pt] = MFMA16(xf, mf, ya[pt]); } } }
        const bf16* hp = HIN + (((size_t)b * 16 + c) * 24 + hh) * 4096;
#pragma unroll
        for (int pt = 0; pt < 4; ++pt)
#pragma unroll
            for (int ks = 0; ks < 2; ++ks) { const bf16x8 hf = *(const bf16x8*)(hp + (16 * pt + i) * 64 + 32 * ks + 8 * g4); yo[pt] = MFMA16(hf, Cf[ks], yo[pt]); }
        const float el = __expf(al);
#pragma unroll
        for (int pt = 0; pt < 4; ++pt) { const s16x4 z4 = *(const s16x4*)(PROJ + grow * NPROJ + PZ + 64 * hh + 16 * pt + 4 * g4);
            float yy[4];
#pragma unroll
            for (int r = 0; r < 4; ++r) { const float y = (ya[pt][r] + el * yo[pt][r]) * silu_f(bf2f(z4[r])); yy[r] = y; ssq += y * y; }
            v2u pk; pk.x = cvt_pk_bf16(yy[0], yy[1]); pk.y = cvt_pk_bf16(yy[2], yy[3]);
            *(v2u*)(Y + grow * DMIX + 64 * hh + 16 * pt + 4 * g4) = pk; } }
    ssq += __shfl_xor(ssq, 16); ssq += __shfl_xor(ssq, 32);
    const float rs = 1.0f / sqrtf(ssq * (1.0f / 384.0f) + EPS);
    VM_WAIT();
#pragma unroll 2
    for (int hp2 = 0; hp2 < 24; ++hp2) { const int col = 384 * g + 16 * hp2 + 4 * g4; const f32x4 nw = *(const f32x4*)(ssd_norm_w + col);
        const v2u yb = *(const v2u*)(Y + grow * DMIX + col);
        v2u pk; pk.x = cvt_pk_bf16(__uint_as_float(yb.x << 16) * rs * nw[0], __uint_as_float(yb.x & 0xffff0000u) * rs * nw[1]); pk.y = cvt_pk_bf16(__uint_as_float(yb.y << 16) * rs * nw[2], __uint_as_float(yb.y & 0xffff0000u) * rs * nw[3]);
        *(v2u*)(Y + grow * DMIX + col) = pk; }
    __syncthreads();
}

struct Args { const float* in[23]; float* out; unsigned char* ws; int ph_lo, ph_hi; };
constexpr int NPHASE = 9;
#define MK_EN(k) (((MASK) >> (k)) & 1)

template <int MASK> __global__ void __launch_bounds__(NT, 2) mk_fwd(Args args) {
    extern __shared__ __attribute__((aligned(16))) unsigned char lds_raw[];
    Ctx F;
    F.lds = (LAS unsigned char*)lds_raw;
    F.wave = __builtin_amdgcn_readfirstlane(threadIdx.x >> 6);
#define REFRESH() do { F.lane = lane_now(); F.tid = F.wave * 64 + F.lane; } while (0)
    REFRESH();
    F.G = gridDim.x; { const int bx = blockIdx.x; F.vcu = (F.G % 8 == 0) ? (bx % 8) * (F.G / 8) + bx / 8 : bx; }
    volatile LAS unsigned* MISC = (volatile LAS unsigned*)(F.lds + MISC_OFF);
    if (F.tid < 128) MISC[F.tid] = 0u;
    __syncthreads();
    unsigned char* ws = args.ws; float* out = args.out;
    unsigned* ctl = (unsigned*)(ws + WS_CTL);
    const int lo = args.ph_lo, hi = args.ph_hi;
    XcdBarrier bar; bar.bar = ctl + CW_BAR; bar.x = 0; bar.st = nullptr;
    if (hi - lo > 1) bar = xcd_barrier_post(ctl + CW_BAR, MISC + 8, F.tid == 0);
#define IN(k) (lo <= (k) && (k) < hi)
#define SEAM(k) do { REFRESH(); if (IN(k) && IN((k) + 1)) xcd_barrier(bar, F.tid == 0); REFRESH(); } while (0)
    bf16* Win_t = (bf16*)(ws + WS_WIN); bf16* Wout_t = (bf16*)(ws + WS_WOUT); bf16* Wup_t = (bf16*)(ws + WS_WUP); bf16* Wdn_t = (bf16*)(ws + WS_WDN);
    bf16* Wdt_t = (bf16*)(ws + WS_WDT); bf16* PWt = (bf16*)(ws + WS_PWT);
    bf16* XN1 = (bf16*)(ws + WS_A); bf16* HIN = (bf16*)(ws + WS_A); bf16* X1b = (bf16*)(ws + WS_A);
    bf16* PROJ = (bf16*)(ws + WS_B); bf16* Hb = (bf16*)(ws + WS_B + WB_H); float* UT = (float*)(ws + WS_B + WB_UT); float* UH = (float*)(ws + WS_B + WB_UH);
    float* SSP = (float*)(ws + WS_B + WB_SSP); float* SSP2 = (float*)(ws + WS_B + WB_SSP2); bf16* HS = (bf16*)(ws + WS_B + WB_HS); float* X2S = (float*)(ws + WS_B + WB_X2S);
    bf16* Y = (bf16*)(ws + WS_Y); float* DT = (float*)(ws + WS_DT); float* CDEC = (float*)(ws + WS_CDEC);
    float* X1S = (float*)(ws + WS_X1S); bf16* XN2S = (bf16*)(ws + WS_XN2S); bf16* XN1S = (bf16*)(ws + WS_XN1S);
    float* PROJS = out + OS_PROJS; float* DTS = out + OS_DTS; bf16* YS = (bf16*)(out + OS_YS);
    float* CS = out + O_YP;
    float* X1 = out + O_YP;
    const int gw = F.vcu * NWAVES + F.wave, NGW = F.G * NWAVES;
    LAS float* redl = (LAS float*)F.lds;

    if (IN(0) && MK_EN(0)) {
        LAS float* scr = (LAS float*)(F.lds + F.wave * 16384);
        constexpr int I1 = 16 * 112, I2 = 16 * 16, I3 = 32 * 32, I4 = 16 * 176, I5 = 44 * 32, I6 = 32, I7 = 16, NITEMS = I1 + I2 + I3 + I4 + I5 + I6 + I7;
        for (int it = gw; it < NITEMS; it += NGW) {
            int r = it;
            if (r < I1) { transpose_item(w_in, INC, 64 * (r / 112), 32 * (r % 112), 32, Win_t, 1024, 32 * (r % 112), nullptr, scr, F.lane); continue; } r -= I1;
            if (r < I2) { transpose_item(w_in, INC, 64 * (r / 16), 3608 + 32 * (r % 16), 32, Win_t, 1024, 3584 + 32 * (r % 16), nullptr, scr, F.lane); continue; } r -= I2;
            if (r < I3) { transpose_item(w_out, 1024, 64 * (r / 32), 32 * (r % 32), 32, Wout_t, 2048, 32 * (r % 32), nullptr, scr, F.lane); continue; } r -= I3;
            if (r < I4) { const int j = 32 * (r % 176); const int drow = (j < DFF) ? 256 * (j / 128) + (j % 128) : 256 * ((j - DFF) / 128) + 128 + ((j - DFF) % 128);
                          transpose_item(w_up, UPN, 64 * (r / 176), j, 32, Wup_t, 1024, drow, norm2_w, scr, F.lane); continue; } r -= I4;
            if (r < I5) { transpose_item(w_down, 1024, 64 * (r / 32), 32 * (r % 32), 32, Wdn_t, DFF, 32 * (r % 32), nullptr, scr, F.lane); continue; } r -= I5;
            if (r < I6) { const int g = r >> 3, rr = r & 7; transpose_item(pool_w + (size_t)g * 16384, 128, 64 * (rr >> 2), 32 * (rr & 3), 32, PWt + (size_t)g * 16384, 128, 32 * (rr & 3), nullptr, scr, F.lane); continue; } r -= I6;
            transpose_item(w_in, INC, 64 * r, 3584, 24, Wdt_t, 1024, 0, nullptr, scr, F.lane);
        }
        { float* fcw = (float*)(ws + WS_FCW);
          for (int j = F.vcu * NT + F.tid; j < 4 * UPN; j += F.G * NT) fcw[j] = (j < 3 * UPN) ? ffn_conv_w[j] : ffn_conv_b[j - 3 * UPN]; }
        for (int m = gw; m < MP + NS; m += NGW) {
            if (m < MP) rms_row_to_bf16(x_prompt + (size_t)m * DM, norm1_w, XN1 + (size_t)m * DM, F.lane);
            else rms_row_to_bf16(x_sample + (size_t)(m - MP) * DM, norm1_w, XN1S + (size_t)(m - MP) * DM, F.lane);
        }
        __syncthreads();
    }
    SEAM(0);

    if (IN(1) && MK_EN(1)) {
        const int i = F.lane & 15, g4 = F.lane >> 4;
        for (int blk = F.vcu; blk < MP / 64; blk += F.G) {
            const int mt = F.wave >> 1, nt = F.wave & 1;
            const bf16* ap = XN1 + (size_t)(blk * 64 + mt * 16 + i) * DM + 8 * g4; const bf16* bp = Wdt_t + (size_t)(nt * 16 + i) * DM + 8 * g4;
            f32x4 acc = (f32x4){0.f, 0.f, 0.f, 0.f};
#pragma unroll 8
            for (int ks = 0; ks < 32; ++ks) acc = MFMA16(*(const bf16x8*)(ap + 32 * ks), *(const bf16x8*)(bp + 32 * ks), acc);
            const int h = nt * 16 + i;
            if (h < NH) { const float bias = dt_bias[h];
#pragma unroll
                for (int r = 0; r < 4; ++r) DT[(size_t)(blk * 64 + mt * 16 + 4 * g4 + r) * 24 + h] = softplus_f(acc[r] + bias); }
        }
        for (int sl = F.vcu; sl < 256 + 2; sl += F.G) {
            f32x4 acc[8];
            const bool isdt = sl >= 256; const int n0 = isdt ? 16 * (sl - 256) : 16 * sl;
            skinny_acc<8, 1024>(XN1S, isdt ? Wdt_t : Win_t, 0, n0, F.wave, F.lane, acc);
            const f32x4 s = skinny_reduce<8>(redl, acc, F.wave, F.lane, F.tid);
            const int col = n0 + (F.tid & 15), rowb = 16 * (F.tid >> 6) + 4 * ((F.tid & 63) >> 4);
            if (!isdt) {
#pragma unroll
                for (int r = 0; r < 4; ++r) PROJS[(size_t)(rowb + r) * NPROJ + col] = s[r]; }
            else if (col < NH) { const float bias = dt_bias[col];
#pragma unroll
                for (int r = 0; r < 4; ++r) DTS[(rowb + r) * 24 + col] = softplus_f(s[r] + bias); }
        }
        __syncthreads();
        pg8::Gemm gm{XN1, Win_t, MP, NPROJ, DM}; pg8::StaticOrder S; S.init(MP, NPROJ, F.G, (int)blockIdx.x);
        pg8::EpiStoreBf16 E{PROJ, NPROJ};
        pg8::gemm_phase<pg8::EpiStoreBf16, pg8::StaticOrder, true, true>(F.lds + RING_OFF, gm, S, E, F.tid);
    }
    SEAM(1);

    if (IN(2) && MK_EN(2)) {
        for (int u = F.vcu; u < 512 + 512 + 512 + 128; u += F.G) {
            if (u < 512) s1_unit(F, PROJ, DT, CS, CDEC, out + O_CONVP, u);
            else if (u < 1024) pool_unit(F, PROJ, PWt, Y, out + O_POOLP, u - 512);
            else if (u < 1536) ssm_sample_unit(F, out, u - 1024);
            else pool_sample_unit(F, out, u - 1536);
        }
    }
    SEAM(2);

    if (IN(3) && MK_EN(3)) {
        for (int it = F.vcu * NT + F.tid; it < NB * NH * 64 * 16; it += F.G * NT) {
            const int n4 = it & 15, p = (it >> 4) & 63, hh = (it >> 10) % NH, b = (it >> 10) / NH;
            f32x4 cs[16];
#pragma unroll
            for (int c = 0; c < 16; ++c) cs[c] = *(const f32x4*)(CS + ((((size_t)b * 16 + c) * NH + hh) * 64 + p) * 64 + 4 * n4);
            f32x4 h = (f32x4){0.f, 0.f, 0.f, 0.f};
#pragma unroll
            for (int c = 0; c < 16; ++c) { v2u pk; pk.x = cvt_pk_bf16(h[0], h[1]); pk.y = cvt_pk_bf16(h[2], h[3]);
                *(v2u*)(HIN + ((((size_t)b * 16 + c) * NH + hh) * 64 + p) * 64 + 4 * n4) = pk;
                h = h * CDEC[(b * 16 + c) * NH + hh] + cs[c]; }
            *(f32x4*)(out + O_SSMP + (((size_t)b * NH + hh) * 64 + p) * 64 + 4 * n4) = h;
        }
        for (int sl = F.vcu; sl < 256; sl += F.G) {
            const int rt = sl >> 6, nt = sl & 63; f32x4 acc[2];
            skinny_acc<2, 2048>(YS, Wout_t, 32 * rt, 16 * nt, F.wave, F.lane, acc);
            const f32x4 s = skinny_reduce<2>(redl, acc, F.wave, F.lane, F.tid);
            if ((F.tid >> 6) < 2) { const int col = 16 * nt + (F.tid & 15), rowb = 32 * rt + 16 * (F.tid >> 6) + 4 * ((F.tid & 63) >> 4);
#pragma unroll
                for (int r = 0; r < 4; ++r) X1S[(size_t)(rowb + r) * DM + col] = s[r] + x_sample[(size_t)(rowb + r) * DM + col]; }
        }
    }
    SEAM(3);

    if (IN(4) && MK_EN(4)) {
        for (int u = F.vcu; u < 512; u += F.G) s3_unit(F, PROJ, DT, HIN, Y, u);
        for (int m = gw; m < NS; m += NGW) rms_row_to_bf16(X1S + (size_t)m * DM, nullptr, XN2S + (size_t)m * DM, F.lane);
    }
    SEAM(4);

    if (IN(5) && MK_EN(5)) {
        for (int sl = F.vcu; sl < 352; sl += F.G) {
            const int rt = sl / 176, ct = sl % 176, c0 = 16 * ct, ng0 = 256 * (c0 >> 7) + (c0 & 127);
            f32x4 acc[4];
            skinny_acc<4, 1024>(XN2S, Wup_t, 64 * rt, ng0, F.wave, F.lane, acc);
            const f32x4 sg = skinny_reduce<4>(redl, acc, F.wave, F.lane, F.tid);
            skinny_acc<4, 1024>(XN2S, Wup_t, 64 * rt, ng0 + 128, F.wave, F.lane, acc);
            const f32x4 sv = skinny_reduce<4>(redl, acc, F.wave, F.lane, F.tid);
            if ((F.tid >> 6) < 4) { const int ch = c0 + (F.tid & 15), rowb = 64 * rt + 16 * (F.tid >> 6) + 4 * ((F.tid & 63) >> 4);
                const float wg0 = ffn_conv_w[ch], wg1 = ffn_conv_w[UPN + ch], wg2 = ffn_conv_w[2 * UPN + ch], bg = ffn_conv_b[ch];
                const float wv0 = ffn_conv_w[DFF + ch], wv1 = ffn_conv_w[UPN + DFF + ch], wv2 = ffn_conv_w[2 * UPN + DFF + ch], bv = ffn_conv_b[DFF + ch];
#pragma unroll
                for (int r = 0; r < 4; ++r) { const int bb = rowb + r; const float* st = state_ffn + (size_t)bb * 2 * UPN; float* fo = out + O_FFNS + (size_t)bb * 2 * UPN;
                    const float g0 = st[ch], g1 = st[UPN + ch], v0 = st[DFF + ch], v1 = st[UPN + DFF + ch];
                    const float ug = bg + wg0 * g0 + wg1 * g1 + wg2 * sg[r], uv = bv + wv0 * v0 + wv1 * v1 + wv2 * sv[r];
                    HS[(size_t)bb * DFF + ch] = f2bf(silu_f(ug) * uv);
                    fo[ch] = g1; fo[UPN + ch] = sg[r]; fo[DFF + ch] = v1; fo[UPN + DFF + ch] = sv[r]; } }
        }
        __syncthreads();
        pg8::Gemm gm{Y, Wout_t, MP, DM, DMIX}; pg8::StaticOrder S; S.init(MP, DM, F.G, (int)blockIdx.x);
        pg8::EpiResid<true> E{x_prompt, X1, X1b, SSP};
        pg8::gemm_phase<pg8::EpiResid<true>, pg8::StaticOrder, true, true>(F.lds + RING_OFF, gm, S, E, F.tid);
    }
    SEAM(5);

    if (IN(6) && MK_EN(6)) {
        for (int sl = F.vcu; sl < 256; sl += F.G) {
            const int rt = sl >> 6, nt = sl & 63; f32x4 acc[2];
            skinny_acc<2, 2816>(HS, Wdn_t, 32 * rt, 16 * nt, F.wave, F.lane, acc);
            const f32x4 s = skinny_reduce<2>(redl, acc, F.wave, F.lane, F.tid);
            if ((F.tid >> 6) < 2) { const int col = 16 * nt + (F.tid & 15), rowb = 32 * rt + 16 * (F.tid >> 6) + 4 * ((F.tid & 63) >> 4);
#pragma unroll
                for (int r = 0; r < 4; ++r) X2S[(size_t)(rowb + r) * DM + col] = s[r] + X1S[(size_t)(rowb + r) * DM + col]; }
        }
        __syncthreads();
        pg8::Gemm gm{X1b, Wup_t, MP, UPN, DM}; pg8::StaticOrder S; S.init(MP, UPN, F.G, (int)blockIdx.x);
        typedef pg8::EpiUp<WS_B + WB_H, WS_B + WB_UT, WS_B + WB_UH, WS_B + WB_SSP, WS_FCW> EpiUpT;
        EpiUpT E{ws, out + O_FFNP, (PG8_LAS float*)(F.lds + EX_OFF)};
        pg8::gemm_phase<EpiUpT, pg8::StaticOrder, true, true>(F.lds + RING_OFF, gm, S, E, F.tid);
    }
    SEAM(6);

    if (IN(7) && MK_EN(7)) {
        for (int m = gw; m < NS; m += NGW) {
            const f32x4* xr = (const f32x4*)(X2S + (size_t)m * DM) + F.lane; f32x4 v[4]; float s = 0.f;
#pragma unroll
            for (int j = 0; j < 4; ++j) { v[j] = xr[64 * j]; s += (v[j][0] * v[j][0] + v[j][1] * v[j][1]) + (v[j][2] * v[j][2] + v[j][3] * v[j][3]); }
            const float rs = 1.0f / sqrtf(wave_sum(s) * (1.0f / 1024.0f) + EPS);
            f32x4* yo = (f32x4*)(out + O_YS + (size_t)m * DM) + F.lane;
#pragma unroll
            for (int j = 0; j < 4; ++j) yo[64 * j] = v[j] * rs * ((const f32x4*)final_norm_w)[F.lane + 64 * j];
        }
        pg8::StaticOrder S; S.init(MP, DM, F.G, (int)blockIdx.x);
        { pg8::Unit u;
          for (int ui = 0; S.next(ui, u); ++ui) { const int pm = u.pm; if ((pm & 7) == 0) continue;
            for (int j = F.tid; j < DFF; j += NT) { const int gi = 256 * (j >> 7) + (j & 127), vi = gi + 128;
                const float* t0 = UT + (size_t)(pm - 1) * 2 * UPN; const float* h0 = UH + (size_t)pm * 2 * UPN;
                const float gm2 = t0[gi], gm1 = t0[UPN + gi], g0 = h0[gi], g1 = h0[UPN + gi];
                const float vm2 = t0[vi], vm1 = t0[UPN + vi], v0 = h0[vi], v1 = h0[UPN + vi];
                const float wg0 = ffn_conv_w[j], wg1 = ffn_conv_w[UPN + j], wg2 = ffn_conv_w[2 * UPN + j], bg = ffn_conv_b[j];
                const float wv0 = ffn_conv_w[DFF + j], wv1 = ffn_conv_w[UPN + DFF + j], wv2 = ffn_conv_w[2 * UPN + DFF + j], bv = ffn_conv_b[DFF + j];
                const float ug0 = bg + wg0 * gm2 + wg1 * gm1 + wg2 * g0, ug1 = bg + wg0 * gm1 + wg1 * g0 + wg2 * g1;
                const float uv0 = bv + wv0 * vm2 + wv1 * vm1 + wv2 * v0, uv1 = bv + wv0 * vm1 + wv1 * v0 + wv2 * v1;
                Hb[(size_t)(256 * pm) * DFF + j] = f2bf(silu_f(ug0) * uv0); Hb[(size_t)(256 * pm + 1) * DFF + j] = f2bf(silu_f(ug1) * uv1); } } }
        VM_WAIT(); __syncthreads();
        pg8::Gemm gm{Hb, Wdn_t, MP, DM, DFF};
        pg8::EpiResid<false> E{X1, X1, nullptr, SSP2};
        pg8::gemm_phase<pg8::EpiResid<false>, pg8::StaticOrder, true, true>(F.lds + RING_OFF, gm, S, E, F.tid);
    }
    SEAM(7);

    if (IN(8) && MK_EN(8)) {
        for (int m = gw; m < MP; m += NGW) {
            f32x4* xr = (f32x4*)(out + O_YP + (size_t)m * DM) + F.lane; f32x4 v[4];
#pragma unroll
            for (int j = 0; j < 4; ++j) v[j] = xr[64 * j];
            const f32x4* pp = (const f32x4*)(SSP2 + (size_t)m * 16); const f32x4 p0 = pp[0], p1 = pp[1], p2 = pp[2], p3 = pp[3];
            const float s = ((p0[0] + p0[1]) + (p0[2] + p0[3])) + ((p1[0] + p1[1]) + (p1[2] + p1[3])) + ((p2[0] + p2[1]) + (p2[2] + p2[3])) + ((p3[0] + p3[1]) + (p3[2] + p3[3]));
            const float rs = 1.0f / sqrtf(s * (1.0f / 1024.0f) + EPS);
#pragma unroll
            for (int j = 0; j < 4; ++j) xr[64 * j] = v[j] * rs * ((const f32x4*)final_norm_w)[F.lane + 64 * j];
        }
    }
#undef IN
#undef SEAM
}
#undef x_prompt
#undef x_sample
#undef state_ssm
#undef state_conv
#undef state_pool
#undef state_ffn
#undef norm1_w
#undef w_in
#undef conv_w
#undef conv_b
#undef dt_bias
#undef a_log
#undef d_skip
#undef ssd_norm_w
#undef pool_w
#undef pool_scale
#undef w_out
#undef norm2_w
#undef w_up
#undef ffn_conv_w
#undef ffn_conv_b
#undef w_down
#undef final_norm_w
}

#ifndef MK_PER_PHASE
#define MK_PER_PHASE 0
#endif
extern "C" void kernel_launch(void* const* d_in, const int* in_sizes, int n_in, void* d_out, int out_size, void* d_ws, size_t ws_size, hipStream_t stream) {
    using namespace mk;
    static int grid = 0;
    if (grid == 0) {
        if (n_in != 23 || in_sizes[0] != MP * DM || out_size != (int)O_END || ws_size < WS_END) {
            fprintf(stderr, "kernel_launch: unexpected problem (n_in %d, in0 %d, out %d, ws %zu); nothing launched\n", n_in, n_in > 0 ? in_sizes[0] : -1, out_size, ws_size); grid = -1; return; }
        int dev = 0, cus = 0, per_cu = 0;
        if (hipGetDevice(&dev) != hipSuccess || hipDeviceGetAttribute(&cus, hipDeviceAttributeMultiprocessorCount, dev) != hipSuccess) { fprintf(stderr, "kernel_launch: device query failed\n"); grid = -1; return; }
#if MK_PER_PHASE
        const void* fns[9] = {(const void*)mk_fwd<1>, (const void*)mk_fwd<2>, (const void*)mk_fwd<4>, (const void*)mk_fwd<8>, (const void*)mk_fwd<16>, (const void*)mk_fwd<32>, (const void*)mk_fwd<64>, (const void*)mk_fwd<128>, (const void*)mk_fwd<256>};
        const int nfn = 9;
#else
        const void* fns[1] = {(const void*)mk_fwd<0x1FF>};
        const int nfn = 1;
#endif
        for (int i = 0; i < nfn; ++i)
            if (hipFuncSetAttribute(fns[i], hipFuncAttributeMaxDynamicSharedMemorySize, LDS_BYTES) != hipSuccess) { fprintf(stderr, "kernel_launch: hipFuncSetAttribute(%d B LDS) failed\n", LDS_BYTES); grid = -1; return; }
        if (hipOccupancyMaxActiveBlocksPerMultiprocessor(&per_cu, fns[0], NT, LDS_BYTES) != hipSuccess || per_cu < 1) {
            fprintf(stderr, "kernel_launch: occupancy query reports %d workgroups per CU; nothing launched\n", per_cu); (void)hipGetLastError(); grid = -1; return; }
        grid = cus;
    }
    if (grid < 0) return;
    if (hipMemsetAsync((char*)d_ws + WS_CTL, 0, CTL_BYTES, stream) != hipSuccess) { fprintf(stderr, "kernel_launch: memset failed\n"); return; }
    Args a{};
    for (int i = 0; i < 23; ++i) a.in[i] = (const float*)d_in[i];
    a.out = (float*)d_out; a.ws = (unsigned char*)d_ws;
#if MK_PER_PHASE
#define MK_LAUNCH(p) do { a.ph_lo = p; a.ph_hi = p + 1; hipLaunchKernelGGL(mk_fwd<(1 << p)>, dim3(grid), dim3(NT), LDS_BYTES, stream, a); } while (0)
    MK_LAUNCH(0); MK_LAUNCH(1); MK_LAUNCH(2); MK_LAUNCH(3); MK_LAUNCH(4); MK_LAUNCH(5); MK_LAUNCH(6); MK_LAUNCH(7); MK_LAUNCH(8);
#else
    a.ph_lo = 0; a.ph_hi = NPHASE;
    hipLaunchKernelGGL(mk_fwd<0x1FF>, dim3(grid), dim3(NT), LDS_BYTES, stream, a);
#endif
    const hipError_t le = hipPeekAtLastError();
    if (le != hipSuccess) fprintf(stderr, "kernel_launch: launch failed: %s\n", hipGetErrorName(le));
}
```

```cpp
#include <hip/hip_runtime.h>
#include <cstdio>
#include <cstdint>
namespace pg8 {
#define PG8_LAS __attribute__((address_space(3)))
typedef unsigned short bf16_t;
typedef short bf16x8 __attribute__((ext_vector_type(8)));
typedef float f32x4 __attribute__((ext_vector_type(4)));
typedef unsigned u32x4 __attribute__((ext_vector_type(4)));
constexpr int BM = 256, BK = 64, HALF = 128, HTB = HALF * BK * 2  , STAGE_BYTES = 8 * HTB, NXCD = 8, WGM = 8;

__host__ __device__ __forceinline__ int lds_byte(int r, int c) { const int st = (r >> 4) * 2 + (c >> 5), rr = r & 15, cc = c & 31, ob = rr * 64 + cc * 2; return st * 1024 + (ob ^ (((ob >> 9) & 1) << 5)); }
__host__ __device__ __forceinline__ void stage_rc(int b, int& R, int& C) { const int st = b / 1024, sb = b % 1024, swz = sb ^ (((sb >> 9) & 1) << 5); R = (st >> 1) * 16 + swz / 64; C = (st & 1) * 32 + (swz % 64) / 2; }
__host__ __device__ __forceinline__ int perm32(int rho) { const int n = rho >> 4, i = rho & 15; return 8 * (i >> 2) + 4 * n + (i & 3); }

struct Unit { int pm, pn; };
struct Gemm { const bf16_t* A; const bf16_t* Bt; int M, N, K; };

struct StaticOrder {
    int nM, nN, nwg, G, c;
    __host__ __device__ void init(int M, int N, int G_, int c_) { nM = M / BM; nN = N / BM; nwg = nM * nN; G = G_; c = c_; }
    __host__ __device__ bool next(int i, Unit& u) const {
        const long L = (long)i * G + c; if (L >= nwg) return false;
        int wgid = (int)L; { const int q = nwg / NXCD, r = nwg % NXCD, xcd = wgid % NXCD, off = wgid / NXCD; wgid = (xcd < r ? xcd * (q + 1) : r * (q + 1) + (xcd - r) * q) + off; }
        const int nig = WGM * nN, gid = wgid / nig, fm = gid * WGM, gsz = (nM - fm) < WGM ? (nM - fm) : WGM;
        u.pm = fm + ((wgid % nig) % gsz); u.pn = (wgid % nig) / gsz; return true;
    }
    __device__ __forceinline__ void a_ready(const Unit&) const {}
    __device__ __forceinline__ void done(const Unit&) const {}
};

__device__ __forceinline__ unsigned cvt_pk_bf16(float lo, float hi) { unsigned r; asm volatile("v_cvt_pk_bf16_f32 %0, %1, %2" : "=v"(r) : "v"(lo), "v"(hi)); return r; }
typedef float f32x2 __attribute__((ext_vector_type(2)));
typedef unsigned u32x2 __attribute__((ext_vector_type(2)));
__device__ __forceinline__ float silu_f(float x) { return x * __builtin_amdgcn_rcpf(1.0f + __expf(-x)); }
__device__ __forceinline__ float dpp_ror1(float v) { return __builtin_bit_cast(float, __builtin_amdgcn_update_dpp(0, __builtin_bit_cast(int, v), 0x121, 0xf, 0xf, false)); }
__device__ __forceinline__ float dpp_ror2(float v) { return __builtin_bit_cast(float, __builtin_amdgcn_update_dpp(0, __builtin_bit_cast(int, v), 0x122, 0xf, 0xf, false)); }

struct EpiStoreBf16 {
    static constexpr bool PERM = true, AFTER_DRAIN = false;
    bf16_t* O; int ldc;
    __device__ __forceinline__ void operator()(f32x4 (&acc)[2][2][4][2], const Unit& u, int wr, int wc, int fr, int fq) const {
        const int row0 = u.pm * BM + wr * 64 + fr, col0 = u.pn * BM + wc * 32 + 8 * fq;
#pragma unroll
        for (int ai = 0; ai < 2; ++ai)
#pragma unroll
            for (int m = 0; m < 4; ++m) { bf16_t* rowp = O + (size_t)(row0 + ai * HALF + m * 16) * ldc + col0;
#pragma unroll
                for (int bj = 0; bj < 2; ++bj) { const f32x4 v0 = acc[ai][bj][m][0], v1 = acc[ai][bj][m][1];
                    u32x4 w; w.x = cvt_pk_bf16(v0[0], v0[1]); w.y = cvt_pk_bf16(v0[2], v0[3]); w.z = cvt_pk_bf16(v1[0], v1[1]); w.w = cvt_pk_bf16(v1[2], v1[3]);
                    *(u32x4*)(rowp + bj * HALF) = w; } }
    }
};

template <bool WITH_BF16> struct EpiResid {
    static constexpr bool PERM = false, AFTER_DRAIN = false;
    const float* xin; float* xo; bf16_t* xb; float* ssp;
    __device__ __forceinline__ void operator()(f32x4 (&acc)[2][2][4][2], const Unit& u, int wr, int wc, int fr, int fq) const {
        const int row0 = u.pm * BM + wr * 64 + fr, col0 = u.pn * BM + wc * 32 + 4 * fq;
#pragma unroll
        for (int ai = 0; ai < 2; ++ai)
#pragma unroll
            for (int m = 0; m < 4; ++m) { const int row = row0 + ai * HALF + m * 16; float ss = 0.f;
#pragma unroll
                for (int bj = 0; bj < 2; ++bj)
#pragma unroll
                    for (int n = 0; n < 2; ++n) { const size_t off = (size_t)row * 1024 + col0 + bj * HALF + n * 16;
                        const f32x4 v = acc[ai][bj][m][n] + *(const f32x4*)(xin + off);
                        *(f32x4*)(xo + off) = v; ss += (v[0] * v[0] + v[1] * v[1]) + (v[2] * v[2] + v[3] * v[3]);
                        if (WITH_BF16) { u32x2 w; w.x = cvt_pk_bf16(v[0], v[1]); w.y = cvt_pk_bf16(v[2], v[3]); *(u32x2*)(xb + off) = w; } }
                ss += __shfl_xor(ss, 16); ss += __shfl_xor(ss, 32);
                if (fq == 0) ssp[(size_t)row * 16 + u.pn * 4 + wc] = ss; }
    }
};

struct EpiNull {
    static constexpr bool PERM = true, AFTER_DRAIN = false; float* dummy;
    __device__ __forceinline__ void operator()(f32x4 (&acc)[2][2][4][2], const Unit& u, int wr, int wc, int fr, int fq) const {
        f32x4 s = (f32x4){0.f, 0.f, 0.f, 0.f};
#pragma unroll
        for (int ai = 0; ai < 2; ++ai)
#pragma unroll
            for (int bj = 0; bj < 2; ++bj)
#pragma unroll
                for (int m = 0; m < 4; ++m)
#pragma unroll
                    for (int n = 0; n < 2; ++n) s += acc[ai][bj][m][n];
        dummy[(size_t)(u.pm * 22 + u.pn) * 512 + (wr * 4 + wc) * 64 + fq * 16 + fr] = (s[0] + s[1]) + (s[2] + s[3]);
    }
};
constexpr int UP_EX = 131072, UP_WB = UP_EX + 8192, UP_RS = UP_WB + 8192;
struct UpOrder : StaticOrder {
    const float* fcw; PG8_LAS unsigned char* lds; int wid; mutable int k_;
    __device__ __forceinline__ void a_ready(const Unit& u) const {
        if (wid < 4) { int l; asm volatile("v_mbcnt_lo_u32_b32 %0, -1, 0\n\tv_mbcnt_hi_u32_b32 %0, -1, %0" : "=v"(l));
            const int col = (l < 32) ? 128 * u.pn + 4 * l : 2816 + 128 * u.pn + 4 * (l - 32);
            __builtin_amdgcn_global_load_lds((const unsigned*)(fcw + wid * 5632 + col), (PG8_LAS unsigned*)(lds + UP_WB + (k_ & 1) * 4096 + wid * 1024), 16, 0, 0); }
        ++k_;
    }
};
template <size_t OFF_H, size_t OFF_UT, size_t OFF_UH> struct EpiUp {
    static constexpr bool PERM = true, AFTER_DRAIN = false;
    unsigned char* ws; float* ffn_out; PG8_LAS unsigned char* lds; mutable int ui_;
    __device__ __forceinline__ void operator()(f32x4 (&acc)[2][2][4][2], const Unit& u, int wr, int wc, int fr_, int fq_) const {
        int t_; asm volatile("v_mbcnt_lo_u32_b32 %0, -1, 0\n\tv_mbcnt_hi_u32_b32 %0, -1, %0" : "=v"(t_)); const int fr = t_ & 15, fq = (t_ >> 4) & 3;
        bf16_t* H = (bf16_t*)(ws + OFF_H); float* UT = (float*)(ws + OFF_UT); float* UH = (float*)(ws + OFF_UH);
        PG8_LAS float* ex = (PG8_LAS float*)(lds + UP_EX); const PG8_LAS float* W = (const PG8_LAS float*)(lds + UP_WB + (ui_ & 1) * 4096); const PG8_LAS float* RS = (const PG8_LAS float*)(lds + UP_RS + ui_ * 1024);
        ++ui_;
        const int row0 = u.pm * BM + wr * 64 + fr;
        const int colt = wc * 32 + 8 * fq;
#pragma unroll
        for (int ai = 0; ai < 2; ++ai)
#pragma unroll
            for (int m = 0; m < 4; ++m) { const float rs = RS[ai * HALF + wr * 64 + m * 16 + fr];
#pragma unroll
                for (int bj = 0; bj < 2; ++bj)
#pragma unroll
                    for (int n = 0; n < 2; ++n) acc[ai][bj][m][n] = acc[ai][bj][m][n] * rs; }
        if (fr >= 14) {
#pragma unroll
            for (int ai = 0; ai < 2; ++ai) { const int blk = 2 * ai + wr;
#pragma unroll
                for (int bj = 0; bj < 2; ++bj)
#pragma unroll
                    for (int n = 0; n < 2; ++n) { const int col = bj * HALF + colt + 4 * n; const f32x4 v = acc[ai][bj][3][n];
                        *(PG8_LAS f32x4*)(ex + (blk * 2 + (fr - 14)) * 256 + col) = v;
                        if (blk == 3) { *(f32x4*)(UT + ((size_t)u.pm * 2 + (fr - 14)) * 5632 + u.pn * 256 + col) = v;
                            if ((u.pm & 7) == 7) *(f32x4*)(ffn_out + ((size_t)(u.pm >> 3) * 2 + (fr - 14)) * 5632 + bj * 2816 + u.pn * 128 + colt + 4 * n) = v; } } }
        }
        if (fr < 2 && wr == 0) {
#pragma unroll
            for (int bj = 0; bj < 2; ++bj)
#pragma unroll
                for (int n = 0; n < 2; ++n) *(f32x4*)(UH + ((size_t)u.pm * 2 + fr) * 5632 + u.pn * 256 + bj * HALF + colt + 4 * n) = acc[0][bj][0][n];
        }
        asm volatile("s_waitcnt lgkmcnt(0)" ::: "memory"); __builtin_amdgcn_s_barrier(); asm volatile("" ::: "memory");
#pragma unroll
        for (int ai = 0; ai < 2; ++ai) { const int blk = 2 * ai + wr;
#pragma unroll
            for (int n = 0; n < 2; ++n) {
#pragma unroll
                for (int bj = 0; bj < 2; ++bj) { const int col = bj * HALF + colt + 4 * n; asm volatile("" ::: "memory");
                    const f32x4 w0 = *(const PG8_LAS f32x4*)(W + col), w1 = *(const PG8_LAS f32x4*)(W + 256 + col), w2 = *(const PG8_LAS f32x4*)(W + 512 + col), bb = *(const PG8_LAS f32x4*)(W + 768 + col);
                    f32x4 vprev = (f32x4){0.f, 0.f, 0.f, 0.f};
                    if (blk > 0 && fr >= 14) vprev = *(const PG8_LAS f32x4*)(ex + ((blk - 1) * 2 + (fr - 14)) * 256 + col);
#pragma unroll
                    for (int m = 3; m >= 0; --m) { const f32x4 cur = acc[ai][bj][m][n]; const f32x4 prv = (m > 0) ? acc[ai][bj][m - 1][n] : vprev; f32x4 o;
#pragma unroll
                        for (int e = 0; e < 4; ++e) { const float t1 = (fr == 15) ? prv[e] : cur[e], t2 = (fr >= 14) ? prv[e] : cur[e];
                            o[e] = bb[e] + w0[e] * dpp_ror2(t2) + w1[e] * dpp_ror1(t1) + w2[e] * cur[e]; }
                        acc[ai][bj][m][n] = o; } }
#pragma unroll
                for (int m = 0; m < 4; ++m) { const f32x4 g = acc[ai][0][m][n], v = acc[ai][1][m][n]; f32x4 h;
#pragma unroll
                    for (int e = 0; e < 4; ++e) h[e] = silu_f(g[e]) * v[e];
                    acc[ai][0][m][n] = h; asm volatile("" : "+v"(acc[ai][0][m][n])); } }
#pragma unroll
            for (int m = 0; m < 4; ++m) { const f32x4 h0 = acc[ai][0][m][0], h1 = acc[ai][0][m][1];
                u32x4 w; w.x = cvt_pk_bf16(h0[0], h0[1]); w.y = cvt_pk_bf16(h0[2], h0[3]); w.z = cvt_pk_bf16(h1[0], h1[1]); w.w = cvt_pk_bf16(h1[2], h1[3]);
                *(u32x4*)(H + (size_t)(row0 + ai * HALF + m * 16) * 2816 + u.pn * 128 + colt) = w; } }
    }
};
template <class Epi, class Sched, bool ALIGN_EPI = false, bool SP2 = false>
__device__ __forceinline__ void gemm_phase(PG8_LAS unsigned char* lds, const Gemm g, const Sched& S, const Epi& E, const int tid) {
    const int wid = __builtin_amdgcn_readfirstlane(tid >> 6), lane = tid & 63, wr = wid >> 2, wc = wid & 3, fr = lane & 15, fq = lane >> 4;
    const int K = g.K, nt = K / BK;
    unsigned voffA[2], voffB[2];
#pragma unroll
    for (int i = 0; i < 2; ++i) { int R, C; stage_rc(tid * 16 + i * 8192, R, C); const int Rb = Epi::PERM ? ((R & ~31) + perm32(R & 31)) : R;
        voffA[i] = (unsigned)(R * K + C) * 2u; voffB[i] = (unsigned)(Rb * K + C) * 2u; }
    const size_t kstep = (size_t)(BK * 2);
    const size_t hstep = (size_t)HALF * K * 2;
    const size_t tstep = 2 * hstep;
    const unsigned ldsw = (unsigned)wid * 1024u;
    const int aoff = lds_byte(wr * 64 + fr, fq * 8), boff = lds_byte(wc * 32 + fr, fq * 8);
#define PG8_SA(b, h) (((b) * 2 + (h)) * HTB)
#define PG8_SB(b, h) ((4 + (b) * 2 + (h)) * HTB)
#define PG8_STAGE(bufoff, gbase, voff) do { _Pragma("unroll") for (int _i = 0; _i < 2; ++_i) \
        __builtin_amdgcn_global_load_lds((const unsigned*)((const char*)(gbase) + (voff)[_i]), (PG8_LAS unsigned*)(lds + (bufoff) + ldsw + _i * 8192), 16, 0, 0); } while (0)
#define PG8_LDA(dst, b, h) do { _Pragma("unroll") for (int m = 0; m < 4; ++m) _Pragma("unroll") for (int k = 0; k < 2; ++k) dst[m][k] = *(const PG8_LAS bf16x8*)(lds + PG8_SA(b, h) + aoff + m * 2048 + k * 1024); } while (0)
#define PG8_LDB(dst, b, h) do { _Pragma("unroll") for (int n = 0; n < 2; ++n) _Pragma("unroll") for (int k = 0; k < 2; ++k) dst[n][k] = *(const PG8_LAS bf16x8*)(lds + PG8_SB(b, h) + boff + n * 2048 + k * 1024); } while (0)
#define PG8_MMA(ai, bj, At, Bt) do { __builtin_amdgcn_s_setprio(1); _Pragma("unroll") for (int m = 0; m < 4; ++m) _Pragma("unroll") for (int n = 0; n < 2; ++n) _Pragma("unroll") for (int k = 0; k < 2; ++k) \
        acc[ai][bj][m][n] = __builtin_amdgcn_mfma_f32_16x16x32_bf16(Bt[n][k], At[m][k], acc[ai][bj][m][n], 0, 0, 0); __builtin_amdgcn_s_setprio(0); } while (0)
#define PG8_WAIT_V(n) asm volatile("s_waitcnt vmcnt(" #n ")" ::: "memory")
#define PG8_WAIT_L(n) asm volatile("s_waitcnt lgkmcnt(" #n ")" ::: "memory")
#define PG8_BAR __builtin_amdgcn_s_barrier()
#define PG8_SCHED __builtin_amdgcn_sched_barrier(0)
    Unit cur, nxt; int ui = 0;
    if (!S.next(0, cur)) return;
    f32x4 acc[2][2][4][2];
#pragma unroll
    for (int a = 0; a < 2; ++a)
#pragma unroll
        for (int b = 0; b < 2; ++b)
#pragma unroll
            for (int m = 0; m < 4; ++m)
#pragma unroll
                for (int n = 0; n < 2; ++n) acc[a][b][m][n] = (f32x4){0.f, 0.f, 0.f, 0.f};
    bf16x8 At[4][2], B0[2][2], B1[2][2];
    const char* cA = (const char*)g.A + (size_t)cur.pm * tstep; const char* cB = (const char*)g.Bt + (size_t)cur.pn * tstep;
    S.a_ready(cur);
    if constexpr (SP2) {
        PG8_STAGE(PG8_SB(0, 0), cB, voffB); PG8_STAGE(PG8_SB(0, 1), cB + hstep, voffB); PG8_STAGE(PG8_SA(0, 0), cA, voffA); PG8_STAGE(PG8_SA(0, 1), cA + hstep, voffA);
        if (wr == 1) PG8_BAR;
        PG8_WAIT_V(2); PG8_BAR;
        PG8_STAGE(PG8_SB(1, 0), cB + kstep, voffB); PG8_STAGE(PG8_SA(1, 0), cA + kstep, voffA); PG8_STAGE(PG8_SB(1, 1), cB + hstep + kstep, voffB);
        PG8_WAIT_V(6); PG8_BAR;
    } else {
        PG8_STAGE(PG8_SB(0, 0), cB, voffB); PG8_STAGE(PG8_SA(0, 0), cA, voffA); PG8_STAGE(PG8_SB(0, 1), cB + hstep, voffB); PG8_STAGE(PG8_SA(0, 1), cA + hstep, voffA);
        if (wr == 1) PG8_BAR;
        PG8_WAIT_V(4); PG8_BAR;
        PG8_STAGE(PG8_SB(1, 0), cB + kstep, voffB); PG8_STAGE(PG8_SA(1, 0), cA + kstep, voffA); PG8_STAGE(PG8_SB(1, 1), cB + hstep + kstep, voffB);
        PG8_WAIT_V(6); PG8_BAR;
    }
    for (;;) {
        const bool has_next = S.next(ui + 1, nxt);
        const char* nA = has_next ? (const char*)g.A + (size_t)nxt.pm * tstep : cA; const char* nB = has_next ? (const char*)g.Bt + (size_t)nxt.pn * tstep : cB;
        for (int t = 0; t < nt; t += 2) {
            const bool last = (t == nt - 2);
            const char* a1 = cA + (size_t)(t + 1) * kstep;
            const char* a2 = last ? nA : cA + (size_t)(t + 2) * kstep; const char* b2 = last ? nB : cB + (size_t)(t + 2) * kstep;
            const char* a3 = a2 + kstep; const char* b3 = b2 + kstep;
            if (last && has_next) S.a_ready(nxt);
            if constexpr (SP2) {
            PG8_LDB(B0, 0, 0); PG8_LDB(B1, 0, 1); PG8_SCHED; PG8_LDA(At, 0, 0); PG8_STAGE(PG8_SA(1, 1), a1 + hstep, voffA);
            PG8_WAIT_V(8); PG8_WAIT_L(0); PG8_BAR; PG8_MMA(0, 0, At, B0); PG8_MMA(0, 1, At, B1); PG8_BAR; PG8_SCHED;
            PG8_LDA(At, 0, 1); PG8_STAGE(PG8_SB(0, 0), b2, voffB); PG8_STAGE(PG8_SB(0, 1), b2 + hstep, voffB); PG8_STAGE(PG8_SA(0, 0), a2, voffA);
            PG8_WAIT_V(8); PG8_WAIT_L(0); PG8_BAR; PG8_MMA(1, 0, At, B0); PG8_MMA(1, 1, At, B1); PG8_BAR; PG8_SCHED;
            PG8_LDB(B0, 1, 0); PG8_LDB(B1, 1, 1); PG8_SCHED; PG8_LDA(At, 1, 0); PG8_STAGE(PG8_SA(0, 1), a2 + hstep, voffA);
            PG8_WAIT_V(8); PG8_WAIT_L(0); PG8_BAR; PG8_MMA(0, 0, At, B0); PG8_MMA(0, 1, At, B1); PG8_BAR; PG8_SCHED;
            PG8_LDA(At, 1, 1); PG8_STAGE(PG8_SB(1, 0), b3, voffB); PG8_STAGE(PG8_SB(1, 1), b3 + hstep, voffB); PG8_STAGE(PG8_SA(1, 0), a3, voffA);
            PG8_WAIT_V(8); PG8_WAIT_L(0); PG8_BAR; PG8_MMA(1, 0, At, B0); PG8_MMA(1, 1, At, B1); PG8_BAR; PG8_SCHED;
            } else {
            PG8_LDB(B0, 0, 0); PG8_SCHED; PG8_LDA(At, 0, 0); PG8_STAGE(PG8_SA(1, 1), a1 + hstep, voffA);
            PG8_WAIT_L(8); PG8_BAR; PG8_WAIT_L(0); PG8_MMA(0, 0, At, B0); PG8_BAR; PG8_SCHED;
            PG8_LDB(B1, 0, 1); PG8_STAGE(PG8_SB(0, 0), b2, voffB);
            PG8_BAR; PG8_WAIT_L(0); PG8_MMA(0, 1, At, B1); PG8_BAR;
            PG8_LDA(At, 0, 1); PG8_STAGE(PG8_SA(0, 0), a2, voffA);
            PG8_BAR; PG8_WAIT_L(0); PG8_MMA(1, 0, At, B0); PG8_BAR; PG8_SCHED;
            PG8_STAGE(PG8_SB(0, 1), b2 + hstep, voffB);
            PG8_WAIT_V(6); PG8_BAR; PG8_MMA(1, 1, At, B1); PG8_BAR;
            PG8_LDB(B0, 1, 0); PG8_SCHED; PG8_LDA(At, 1, 0); PG8_STAGE(PG8_SA(0, 1), a2 + hstep, voffA);
            PG8_WAIT_L(8); PG8_BAR; PG8_WAIT_L(0); PG8_MMA(0, 0, At, B0); PG8_BAR; PG8_SCHED;
            PG8_LDB(B1, 1, 1); PG8_STAGE(PG8_SB(1, 0), b3, voffB);
            PG8_BAR; PG8_WAIT_L(0); PG8_MMA(0, 1, At, B1); PG8_BAR;
            PG8_LDA(At, 1, 1); PG8_STAGE(PG8_SA(1, 0), a3, voffA);
            PG8_BAR; PG8_WAIT_L(0); PG8_MMA(1, 0, At, B0); PG8_BAR; PG8_SCHED;
            PG8_STAGE(PG8_SB(1, 1), b3 + hstep, voffB);
            PG8_WAIT_V(6); PG8_BAR; PG8_MMA(1, 1, At, B1); PG8_BAR;
            }
        }
        if constexpr (ALIGN_EPI) { if (wr == 0) PG8_BAR; }
        if constexpr (!Epi::AFTER_DRAIN) { E(acc, cur, wr, wc, fr, fq); S.done(cur); }
        if (!has_next) break;
#pragma unroll
        for (int a = 0; a < 2; ++a)
#pragma unroll
            for (int b = 0; b < 2; ++b)
#pragma unroll
                for (int m = 0; m < 4; ++m)
#pragma unroll
                    for (int n = 0; n < 2; ++n) acc[a][b][m][n] = (f32x4){0.f, 0.f, 0.f, 0.f};
        cur = nxt; cA = nA; cB = nB; ++ui;
        if constexpr (ALIGN_EPI) { if (wr == 1) PG8_BAR; }
    }
    PG8_WAIT_V(0);
    if constexpr (!ALIGN_EPI) { if (wr == 0) PG8_BAR; }
    PG8_BAR;
    if constexpr (Epi::AFTER_DRAIN) { E.fused(acc, cur, wr, wc, fr, fq, lds, wid, lane); S.done(cur); }
#undef PG8_SA
#undef PG8_SB
#undef PG8_STAGE
#undef PG8_LDA
#undef PG8_LDB
#undef PG8_MMA
#undef PG8_WAIT_V
#undef PG8_WAIT_L
#undef PG8_BAR
#undef PG8_SCHED
}
}

namespace mk {
constexpr int NWAVES = 8, NT = 512;
constexpr int DM = 1024, MP = 16384, NS = 128, SEQ = 2048, NB = 8;
constexpr int NPROJ = 4096, INC = 4120, UPN = 5632, DFF = 2816, DMIX = 2048, CONVD = 2048;
constexpr int NH = 24;
constexpr int PZ = 0, PX = 1536, PV = 3584;
constexpr float EPS = 1e-6f;
constexpr size_t O_YP = 0, O_YS = 16777216, O_SSMP = 16908288, O_SSMS = 17694720, O_CONVP = 30277632, O_CONVS = 30326784,
                 O_POOLP = 31113216, O_POOLS = 31174656, O_FFNP = 32157696, O_FFNS = 32247808, O_END = 33689600;
constexpr size_t KiB = 1024, MiB = 1048576;
constexpr size_t WS_CTL = 0, CTL_BYTES = 64 * KiB;
constexpr size_t WS_WIN = 64 * KiB;
constexpr size_t WS_WOUT = WS_WIN + 8 * MiB;
constexpr size_t WS_WUP = WS_WOUT + 4 * MiB;
constexpr size_t WS_WDN = WS_WUP + 11 * MiB;
constexpr size_t WS_WDT = WS_WDN + 5632 * KiB;
constexpr size_t WS_PWT = WS_WDT + 64 * KiB;
constexpr size_t WS_A = WS_PWT + 128 * KiB;
constexpr size_t WS_B = WS_A + 32 * MiB;
constexpr size_t WS_Y = WS_B + 128 * MiB;
constexpr size_t WS_DT = WS_Y + 64 * MiB;
constexpr size_t WS_CDEC = WS_DT + 1536 * KiB;
constexpr size_t WS_X1S = WS_CDEC + 16 * KiB;
constexpr size_t WS_XN2S = WS_X1S + 512 * KiB;
constexpr size_t WS_XN1S = WS_XN2S + 256 * KiB;
constexpr size_t WS_FCW = WS_XN1S + 256 * KiB;
constexpr size_t WS_END = WS_FCW + 128 * KiB;
static_assert(WS_END <= 256 * MiB, "workspace map");
constexpr size_t WB_H = 0, WB_UT = 88 * MiB, WB_UH = 91 * MiB, WB_SSP = 94 * MiB, WB_SSP2 = 95 * MiB, WB_HS = 96 * MiB, WB_X2S = 97 * MiB;
constexpr size_t OS_PROJS = O_FFNS, OS_DTS = O_FFNS + 128 * 4096, OS_YS = OS_DTS + 128 * 32;
static_assert(OS_YS + 131072 <= O_END, "sample scratch");
constexpr int LDS_BYTES = 163840, RING_OFF = 0, EX_OFF = 131072, MISC_OFF = LDS_BYTES - 512;
constexpr int CW_BAR = 4096;

#define LAS __attribute__((address_space(3)))
typedef unsigned short bf16;
typedef unsigned v4u __attribute__((ext_vector_type(4)));
typedef unsigned v2u __attribute__((ext_vector_type(2)));
typedef float f32x4 __attribute__((ext_vector_type(4)));
typedef short bf16x8 __attribute__((ext_vector_type(8)));
typedef short s16x4 __attribute__((ext_vector_type(4)));
#define LDS_WAIT() asm volatile("s_waitcnt lgkmcnt(0)" ::: "memory")
#define VM_WAIT() asm volatile("s_waitcnt vmcnt(0)" ::: "memory")
using pg8::cvt_pk_bf16; using pg8::silu_f;
__device__ __forceinline__ float bf2f(short h) { return __uint_as_float(((unsigned)(unsigned short)h) << 16); }
__device__ __forceinline__ unsigned short f2bf(float f) { return (unsigned short)(cvt_pk_bf16(f, 0.f) & 0xffffu); }
__device__ __forceinline__ float softplus_f(float x) { return x > 20.f ? x : log1pf(__expf(x)); }
__device__ __forceinline__ float wave_sum(float v) {
#pragma unroll
    for (int o = 1; o < 64; o <<= 1) v += __shfl_xor(v, o);
    return v;
}
__device__ __forceinline__ bf16x8 cat8(s16x4 lo, s16x4 hi) { bf16x8 r; r[0] = lo[0]; r[1] = lo[1]; r[2] = lo[2]; r[3] = lo[3]; r[4] = hi[0]; r[5] = hi[1]; r[6] = hi[2]; r[7] = hi[3]; return r; }
__device__ __forceinline__ s16x4 tr_read(const LAS bf16* p) { return __builtin_amdgcn_ds_read_tr16_b64_v4i16((LAS s16x4*)p); }
__device__ __forceinline__ int lane_now() { int t; asm volatile("v_mbcnt_lo_u32_b32 %0, -1, 0\n\tv_mbcnt_hi_u32_b32 %0, -1, %0" : "=v"(t)); return t; }
#define MFMA16(a, b, c) __builtin_amdgcn_mfma_f32_16x16x32_bf16((a), (b), (c), 0, 0, 0)
__device__ __forceinline__ const float* arg_in(int k) { const char* p = (const char*)__builtin_amdgcn_kernarg_segment_ptr(); asm volatile("" : "+s"(p)); return *(const float* const*)(p + 8 * k); }
#define x_prompt (arg_in(0))
#define x_sample (arg_in(1))
#define state_ssm (arg_in(2))
#define state_conv (arg_in(3))
#define state_pool (arg_in(4))
#define state_ffn (arg_in(5))
#define norm1_w (arg_in(6))
#define w_in (arg_in(7))
#define conv_w (arg_in(8))
#define conv_b (arg_in(9))
#define dt_bias (arg_in(10))
#define a_log (arg_in(11))
#define d_skip (arg_in(12))
#define ssd_norm_w (arg_in(13))
#define pool_w (arg_in(14))
#define pool_scale (arg_in(15))
#define w_out (arg_in(16))
#define norm2_w (arg_in(17))
#define w_up (arg_in(18))
#define ffn_conv_w (arg_in(19))
#define ffn_conv_b (arg_in(20))
#define w_down (arg_in(21))
#define final_norm_w (arg_in(22))

#define XB_TMO      128
#define XB_XCNT(j)  (256  + 64 * (j))
#define XB_XSUB(j)  (1280 + 64 * (j))
#define XB_XGEN(j)  (2304 + 64 * (j))
#define XB_TOP      3328
#define XB_TOPGEN   3392
#define XCD_BAR_WORDS 3456
#define XB_SPIN_CAP (1u << 18)

__device__ __forceinline__ unsigned xb_ld(unsigned* p)              { return __hip_atomic_load(p, __ATOMIC_RELAXED, __HIP_MEMORY_SCOPE_AGENT); }
__device__ __forceinline__ unsigned xb_add(unsigned* p, unsigned v) { return __hip_atomic_fetch_add(p, v, __ATOMIC_RELAXED, __HIP_MEMORY_SCOPE_AGENT); }
__device__ __forceinline__ unsigned xb_xcc_id() { return (unsigned)__builtin_amdgcn_s_getreg((3 << 11) | 20) & 0xFu; }
#define XB_SPIN(cond, bar) do { unsigned _sp = 0; while (cond) { __builtin_amdgcn_s_sleep(1); \
    if ((++_sp & 255u) == 0u) { if (xb_ld(&(bar)[XB_TMO])) break; if (_sp > XB_SPIN_CAP) { atomicAdd(&(bar)[XB_TMO], 1u); break; } } } } while (0)

struct XcdBarrier {
    unsigned* bar; unsigned x;
    volatile LAS unsigned* st;
};

__device__ __forceinline__ XcdBarrier xcd_barrier_post(unsigned* bar, volatile LAS unsigned* st, const bool t0) {
    XcdBarrier b; b.bar = bar; b.x = xb_xcc_id(); b.st = st;
    if (t0) (void)xb_add(&bar[XB_XCNT(b.x)], 1u);
    return b;
}
__device__ __forceinline__ void xcd_barrier_complete(unsigned* bar, unsigned x, unsigned& nloc, unsigned& nx) {
    const unsigned G = gridDim.x * gridDim.y * gridDim.z;
    unsigned sum, cnt, mine, sp = 0u;
    for (;;) {
        sum = 0u; cnt = 0u; mine = 0u;
#pragma unroll
        for (unsigned j = 0; j < 16; ++j) { const unsigned c = xb_ld(&bar[XB_XCNT(j)]); sum += c; cnt += (c > 0u) ? 1u : 0u; mine = (j == x) ? c : mine; }
        if (sum == G) break;
        __builtin_amdgcn_s_sleep(1);
        if ((++sp & 255u) == 0u) { if (xb_ld(&bar[XB_TMO])) break; if (sp > XB_SPIN_CAP) { atomicAdd(&bar[XB_TMO], 1u); break; } }
    }
    nloc = mine > 0u ? mine : 1u; nx = cnt > 0u ? cnt : 1u;
}

__device__ __forceinline__ void xcd_barrier(const XcdBarrier& b, const bool t0) {
    asm volatile("s_waitcnt vmcnt(0)" ::: "memory");
    __syncthreads();
    if (t0) {
        unsigned* bar = b.bar;
        __builtin_amdgcn_s_waitcnt(0);
        unsigned nloc = b.st[0], nx = b.st[1];
        if (nloc == 0u) { xcd_barrier_complete(bar, b.x, nloc, nx); b.st[0] = nloc; b.st[1] = nx; }
        const unsigned old = xb_add(&bar[XB_XSUB(b.x)], 1u);
        const unsigned gen = old / nloc;
        if (old + 1u == (gen + 1u) * nloc) {
            __builtin_amdgcn_fence(__ATOMIC_RELEASE, "agent");
            asm volatile("s_waitcnt vmcnt(0)" ::: "memory");
            const unsigned og = xb_add(&bar[XB_TOP], 1u);
            const unsigned tg = og / nx;
            if (og + 1u == (tg + 1u) * nx) xb_add(&bar[XB_TOPGEN], 1u);
            else XB_SPIN(xb_ld(&bar[XB_TOPGEN]) == tg, bar);
            __builtin_amdgcn_fence(__ATOMIC_ACQUIRE, "agent");
            xb_add(&bar[XB_XGEN(b.x)], 1u);
            asm volatile("s_waitcnt vmcnt(0)" ::: "memory");
        } else {
            XB_SPIN(xb_ld(&bar[XB_XGEN(b.x)]) == gen, bar);
            __builtin_amdgcn_fence(__ATOMIC_ACQUIRE, "agent");
            asm volatile("s_waitcnt vmcnt(0)" ::: "memory");
        }
    }
    __syncthreads();
}

struct Ctx { LAS unsigned char* lds; int tid, lane, wave, vcu, G; };

__device__ __forceinline__ void transpose_item(const float* W, int ldw, int k0, int ns0, int nvalid, bf16* WT, int K, int drow0, const float* fold, LAS float* scr, int lane) {
#pragma unroll 8
    for (int i = 0; i < 32; ++i) { const int kk = 2 * i + (lane >> 5), nn = lane & 31;
        float v = (nn < nvalid) ? W[(size_t)(k0 + kk) * ldw + ns0 + nn] : 0.f;
        if (fold) v *= fold[k0 + kk];
        scr[kk * 33 + nn] = v; }
    LDS_WAIT(); asm volatile("" ::: "memory");
    const int c = lane & 7;
#pragma unroll
    for (int j = 0; j < 4; ++j) { const int n = (lane >> 3) + 8 * j; const LAS float* s = scr + (8 * c) * 33 + n;
        v4u o; o.x = cvt_pk_bf16(s[0 * 33], s[1 * 33]); o.y = cvt_pk_bf16(s[2 * 33], s[3 * 33]); o.z = cvt_pk_bf16(s[4 * 33], s[5 * 33]); o.w = cvt_pk_bf16(s[6 * 33], s[7 * 33]);
        *(v4u*)(WT + (size_t)(drow0 + n) * K + k0 + 8 * c) = o; }
    LDS_WAIT(); asm volatile("" ::: "memory");
}
__device__ __forceinline__ void rms_row_to_bf16(const float* xrow, const float* w, bf16* orow, int lane) {
    const f32x4* xr = (const f32x4*)xrow + lane;
    f32x4 v[4]; float s = 0.f;
#pragma unroll
    for (int j = 0; j < 4; ++j) { v[j] = xr[64 * j]; s += (v[j][0] * v[j][0] + v[j][1] * v[j][1]) + (v[j][2] * v[j][2] + v[j][3] * v[j][3]); }
    const float rs = 1.0f / sqrtf(wave_sum(s) * (1.0f / 1024.0f) + EPS);
    v2u* o8 = (v2u*)orow + lane;
#pragma unroll
    for (int j = 0; j < 4; ++j) { f32x4 ww = (f32x4){1.f, 1.f, 1.f, 1.f}; if (w) ww = ((const f32x4*)w)[lane + 64 * j];
        v2u o; o.x = cvt_pk_bf16(v[j][0] * rs * ww[0], v[j][1] * rs * ww[1]); o.y = cvt_pk_bf16(v[j][2] * rs * ww[2], v[j][3] * rs * ww[3]); o8[64 * j] = o; }
}

template <int R16, int K> __device__ __forceinline__ void skinny_acc(const bf16* A, const bf16* Wt, int row0, int n0, int wave, int lane, f32x4 (&acc)[R16]) {
    constexpr int KW = K / 8, NS_ = KW / 32;
    static_assert(KW % 32 == 0, "K split");
    const bf16* ap = A + (size_t)(row0 + (lane & 15)) * K + wave * KW + 8 * (lane >> 4);
    const bf16* bp = Wt + (size_t)(n0 + (lane & 15)) * K + wave * KW + 8 * (lane >> 4);
#pragma unroll
    for (int mi = 0; mi < R16; ++mi) acc[mi] = (f32x4){0.f, 0.f, 0.f, 0.f};
#pragma unroll
    for (int ks = 0; ks < NS_; ++ks) { const bf16x8 b = *(const bf16x8*)(bp + 32 * ks);
#pragma unroll
        for (int mi = 0; mi < R16; ++mi) { const bf16x8 a = *(const bf16x8*)(ap + (size_t)mi * 16 * K + 32 * ks); acc[mi] = MFMA16(a, b, acc[mi]); } }
}
template <int R16> __device__ __forceinline__ f32x4 skinny_reduce(LAS float* red, const f32x4 (&acc)[R16], int wave, int lane, int tid) {
#pragma unroll
    for (int mi = 0; mi < R16; ++mi) *(LAS f32x4*)(red + ((wave * R16 + mi) * 64 + lane) * 4) = acc[mi];
    __syncthreads();
    f32x4 s = (f32x4){0.f, 0.f, 0.f, 0.f};
    if ((tid >> 6) < R16) {
#pragma unroll
        for (int w = 0; w < 8; ++w) s += *(const LAS f32x4*)(red + ((w * R16 + (tid >> 6)) * 64 + (tid & 63)) * 4);
    }
    __syncthreads();
    return s;
}

constexpr int XS = 392, BS = 72;
constexpr int S_XS = 0, S_BS = 128 * XS * 2, S_CS = S_BS + 128 * BS * 2, S_AC = S_CS + 128 * BS * 2, S_DT = S_AC + 6 * 128 * 4, S_WV = S_DT + 6 * 128 * 4, S_END = S_WV + 6 * 128 * 4;
static_assert(S_END <= MISC_OFF, "S-phase LDS map");
template <bool WITH_C> __device__ __forceinline__ void conv_stage(const Ctx& F, const bf16* PROJ, int b, int c, int g, float* conv_out) {
    const int cg = F.tid & 63, rs = F.tid >> 6;
    int ch; LAS bf16* dst; int dstride;
    if (cg < 48) { ch = 384 * g + 8 * cg; dst = (LAS bf16*)(F.lds + S_XS) + 8 * cg; dstride = XS; }
    else if (cg < 56) { ch = 1536 + 64 * g + 8 * (cg - 48); dst = (LAS bf16*)(F.lds + S_BS) + 8 * (cg - 48); dstride = BS; }
    else { ch = 1792 + 64 * g + 8 * (cg - 56); dst = (LAS bf16*)(F.lds + S_CS) + 8 * (cg - 56); dstride = BS; }
    if (!WITH_C && cg >= 56) return;
    float w[4][8], bias[8];
#pragma unroll
    for (int k = 0; k < 4; ++k) { const f32x4 a = *(const f32x4*)(conv_w + k * CONVD + ch), d = *(const f32x4*)(conv_w + k * CONVD + ch + 4);
        w[k][0] = a[0]; w[k][1] = a[1]; w[k][2] = a[2]; w[k][3] = a[3]; w[k][4] = d[0]; w[k][5] = d[1]; w[k][6] = d[2]; w[k][7] = d[3]; }
    { const f32x4 a = *(const f32x4*)(conv_b + ch), d = *(const f32x4*)(conv_b + ch + 4);
        bias[0] = a[0]; bias[1] = a[1]; bias[2] = a[2]; bias[3] = a[3]; bias[4] = d[0]; bias[5] = d[1]; bias[6] = d[2]; bias[7] = d[3]; }
    const bf16* src = PROJ + ((size_t)b * SEQ + c * 128 + 16 * rs) * NPROJ + PX + ch;
    float r0[8], r1[8], r2[8];
    const bool zero_hist = (c == 0 && rs == 0);
    { bf16x8 h0 = {0,0,0,0,0,0,0,0}, h1 = h0, h2 = h0;
      if (!zero_hist) { h0 = *(const bf16x8*)(src - 3 * NPROJ); h1 = *(const bf16x8*)(src - 2 * NPROJ); h2 = *(const bf16x8*)(src - 1 * NPROJ); }
#pragma unroll
      for (int j = 0; j < 8; ++j) { r0[j] = bf2f(h0[j]); r1[j] = bf2f(h1[j]); r2[j] = bf2f(h2[j]); } }
#pragma unroll 4
    for (int i = 0; i < 16; ++i) { const int l = 16 * rs + i;
        const bf16x8 raw = *(const bf16x8*)(src + (size_t)i * NPROJ);
        float cur[8], o[8];
#pragma unroll
        for (int j = 0; j < 8; ++j) { cur[j] = bf2f(raw[j]); o[j] = silu_f(bias[j] + w[0][j] * r0[j] + w[1][j] * r1[j] + w[2][j] * r2[j] + w[3][j] * cur[j]); }
        v4u pk; pk.x = cvt_pk_bf16(o[0], o[1]); pk.y = cvt_pk_bf16(o[2], o[3]); pk.z = cvt_pk_bf16(o[4], o[5]); pk.w = cvt_pk_bf16(o[6], o[7]);
        *(LAS v4u*)(dst + l * dstride) = pk;
        if (conv_out && l >= 125) { float* op = conv_out + (size_t)(l - 125) * CONVD + ch;
            *(f32x4*)op = (f32x4){cur[0], cur[1], cur[2], cur[3]}; *(f32x4*)(op + 4) = (f32x4){cur[4], cur[5], cur[6], cur[7]}; }
#pragma unroll
        for (int j = 0; j < 8; ++j) { r0[j] = r1[j]; r1[j] = r2[j]; r2[j] = cur[j]; } }
}
__device__ __forceinline__ void dt_stage(const Ctx& F, const float* DT, int b, int c, int g, float* cdec_out) {
    if (F.wave < 6) { const int hh = 6 * g + F.wave; const float a = -__expf(a_log[hh]);
        const size_t row = (size_t)b * SEQ + c * 128 + 2 * F.lane;
        const float d0 = DT[row * 24 + hh], d1 = DT[(row + 1) * 24 + hh];
        const float v0 = d0 * a, v1 = d1 * a; float s = v0 + v1;
#pragma unroll
        for (int o = 1; o < 64; o <<= 1) { const float t = __shfl_up(s, o); if (F.lane >= o) s += t; }
        const float tot = __shfl(s, 63);
        LAS float* ac = (LAS float*)(F.lds + S_AC) + F.wave * 128 + 2 * F.lane;
        LAS float* dl = (LAS float*)(F.lds + S_DT) + F.wave * 128 + 2 * F.lane;
        LAS float* wv = (LAS float*)(F.lds + S_WV) + F.wave * 128 + 2 * F.lane;
        const float a0 = s - v1, a1 = s;
        ac[0] = a0; ac[1] = a1; dl[0] = d0; dl[1] = d1; wv[0] = __expf(tot - a0) * d0; wv[1] = __expf(tot - a1) * d1;
        if (cdec_out && F.lane == 0) cdec_out[hh] = __expf(tot); }
}

__device__ __forceinline__ void s1_unit(const Ctx& F, const bf16* PROJ, const float* DT, float* CS, float* CDEC, float* conv_prompt, int unit) {
    const int g = unit & 3, c = (unit >> 2) & 15, b = unit >> 6;
    conv_stage<true>(F, PROJ, b, c, g, (c == 15) ? conv_prompt + (size_t)b * 3 * CONVD : nullptr);
    dt_stage(F, DT, b, c, g, CDEC + (b * 16 + c) * 24);
    __syncthreads();
    const int i = F.lane & 15, g4 = F.lane >> 4;
    const LAS bf16* xs = (const LAS bf16*)(F.lds + S_XS); const LAS bf16* Bs = (const LAS bf16*)(F.lds + S_BS); const LAS float* wv = (const LAS float*)(F.lds + S_WV);
    bf16x8 Bf[4][4];
#pragma unroll
    for (int nt = 0; nt < 4; ++nt)
#pragma unroll
        for (int ks = 0; ks < 4; ++ks) { const LAS bf16* p = Bs + (32 * ks + 4 * g4 + (i >> 2)) * BS + 16 * nt + 4 * (i & 3); Bf[nt][ks] = cat8(tr_read(p), tr_read(p + 16 * BS)); }
#pragma unroll 1
    for (int pr = 0; pr < 3; ++pr) { const int pair = F.wave * 3 + pr, h = pair >> 2, pt = pair & 3;
        bf16x8 Af[4];
#pragma unroll
        for (int ks = 0; ks < 4; ++ks) { const LAS bf16* p = xs + (32 * ks + 4 * g4 + (i >> 2)) * XS + 64 * h + 16 * pt + 4 * (i & 3);
            const s16x4 lo = tr_read(p), hi = tr_read(p + 16 * XS);
            const f32x4 w0 = *(const LAS f32x4*)(wv + h * 128 + 32 * ks + 4 * g4), w1 = *(const LAS f32x4*)(wv + h * 128 + 32 * ks + 16 + 4 * g4);
            v4u pk; pk.x = cvt_pk_bf16(bf2f(lo[0]) * w0[0], bf2f(lo[1]) * w0[1]); pk.y = cvt_pk_bf16(bf2f(lo[2]) * w0[2], bf2f(lo[3]) * w0[3]);
            pk.z = cvt_pk_bf16(bf2f(hi[0]) * w1[0], bf2f(hi[1]) * w1[1]); pk.w = cvt_pk_bf16(bf2f(hi[2]) * w1[2], bf2f(hi[3]) * w1[3]);
            Af[ks] = __builtin_bit_cast(bf16x8, pk); }
        f32x4 acc[4];
#pragma unroll
        for (int nt = 0; nt < 4; ++nt) { acc[nt] = (f32x4){0.f, 0.f, 0.f, 0.f};
#pragma unroll
            for (int ks = 0; ks < 4; ++ks) acc[nt] = MFMA16(Bf[nt][ks], Af[ks], acc[nt]); }
        float* o = CS + ((((size_t)b * 16 + c) * 24 + 6 * g + h) * 64 + 16 * pt + i) * 64 + 4 * g4;
#pragma unroll
        for (int nt = 0; nt < 4; ++nt) *(f32x4*)(o + 16 * nt) = acc[nt]; }
    __syncthreads();
}

constexpr int VS = 136;
constexpr int PL_V = 0, PL_M = 143 * VS * 2;
__device__ __forceinline__ void pool_unit(const Ctx& F, const bf16* PROJ, const bf16* PWt, bf16* Y, float* pool_prompt, int unit) {
    const int g = unit & 3, tt = unit >> 2, b = tt >> 4, t0 = (tt & 15) * 128;
    LAS bf16* vs = (LAS bf16*)(F.lds + PL_V); LAS bf16* ms = (LAS bf16*)(F.lds + PL_M);
    for (int it = F.tid; it < 143 * 16; it += NT) { const int r = it >> 4, cgp = it & 15; const int t = t0 - 15 + r;
        v4u v = (v4u){0u, 0u, 0u, 0u};
        if (t >= 0) v = *(const v4u*)(PROJ + ((size_t)b * SEQ + t) * NPROJ + PV + 128 * g + 8 * cgp);
        *(LAS v4u*)(vs + r * VS + 8 * cgp) = v; }
    __syncthreads();
    const int w = 2 << g;
    for (int it = F.tid; it < 128 * 16; it += NT) { const int l = it >> 4, cgp = it & 15;
        float s[8] = {0.f, 0.f, 0.f, 0.f, 0.f, 0.f, 0.f, 0.f}; bf16x8 cur;
        for (int j = 0; j < w; ++j) { cur = *(const LAS bf16x8*)(vs + (l + 15 - (w - 1) + j) * VS + 8 * cgp);
#pragma unroll
            for (int e = 0; e < 8; ++e) s[e] += bf2f(cur[e]); }
        const int cnt = (t0 + l + 1 < w) ? (t0 + l + 1) : w; const float inv = 1.0f / (float)cnt;
        float o[8];
#pragma unroll
        for (int e = 0; e < 8; ++e) o[e] = s[e] * inv - bf2f(cur[e]);
        v4u pk; pk.x = cvt_pk_bf16(o[0], o[1]); pk.y = cvt_pk_bf16(o[2], o[3]); pk.z = cvt_pk_bf16(o[4], o[5]); pk.w = cvt_pk_bf16(o[6], o[7]);
        *(LAS v4u*)(ms + l * VS + 8 * cgp) = pk; }
    if ((tt & 15) == 15) {
        for (int it = F.tid; it < 15 * 128; it += NT) { const int r = it >> 7, cc = it & 127;
            pool_prompt[((size_t)b * 15 + r) * 512 + 128 * g + cc] = bf2f((short)vs[(128 + r) * VS + cc]); } }
    __syncthreads();
    const int i = F.lane & 15, g4 = F.lane >> 4;
    bf16x8 Af[4];
#pragma unroll
    for (int ks = 0; ks < 4; ++ks) Af[ks] = *(const LAS bf16x8*)(ms + (16 * F.wave + i) * VS + 32 * ks + 8 * g4);
    const size_t row = (size_t)b * SEQ + t0 + 16 * F.wave + i;
#pragma unroll
    for (int nt = 0; nt < 8; ++nt) { f32x4 acc = (f32x4){0.f, 0.f, 0.f, 0.f};
#pragma unroll
        for (int ks = 0; ks < 4; ++ks) { const bf16x8 bfr = *(const bf16x8*)(PWt + ((size_t)g * 128 + 16 * nt + i) * 128 + 32 * ks + 8 * g4); acc = MFMA16(bfr, Af[ks], acc); }
        const f32x4 sc = *(const f32x4*)(pool_scale + 128 * g + 16 * nt + 4 * g4);
        v2u pk; pk.x = cvt_pk_bf16(acc[0] * sc[0], acc[1] * sc[1]); pk.y = cvt_pk_bf16(acc[2] * sc[2], acc[3] * sc[3]);
        *(v2u*)(Y + row * DMIX + 1536 + 128 * g + 16 * nt + 4 * g4) = pk; }
    __syncthreads();
}

__device__ __forceinline__ void ssm_sample_unit(const Ctx& F, float* out, int unit) {
    const float* PROJS = out + OS_PROJS; const float* DTS = out + OS_DTS; bf16* YS = (bf16*)(out + OS_YS); float* ssm_out = out + O_SSMS; float* conv_out = out + O_CONVS;
    const int g = unit & 3, b = unit >> 2, tid = F.tid;
    LAS float* sx = (LAS float*)F.lds;
    LAS float* sy = sx + 512;
    LAS float* sred = sy + 384;
    const int p = tid >> 3, ng = tid & 7;
    f32x4 h0[6][2];
#pragma unroll
    for (int h = 0; h < 6; ++h) { const float* sp = state_ssm + ((((size_t)b * NH + 6 * g + h) * 64 + p) * 64 + 8 * ng); h0[h][0] = *(const f32x4*)sp; h0[h][1] = *(const f32x4*)(sp + 4); }
    { const int ch = (tid < 384) ? 384 * g + tid : (tid < 448 ? 1536 + 64 * g + (tid - 384) : 1792 + 64 * g + (tid - 448));
      const float* st = state_conv + (size_t)b * 3 * CONVD + ch; const float s0 = st[0], s1 = st[CONVD], s2 = st[2 * CONVD], nw = PROJS[(size_t)b * NPROJ + PX + ch];
      sx[tid] = silu_f(conv_b[ch] + conv_w[ch] * s0 + conv_w[CONVD + ch] * s1 + conv_w[2 * CONVD + ch] * s2 + conv_w[3 * CONVD + ch] * nw);
      float* co = conv_out + (size_t)b * 3 * CONVD + ch; co[0] = s1; co[CONVD] = s2; co[2 * CONVD] = nw; }
    __syncthreads();
    float bn[8], cn[8];
#pragma unroll
    for (int j = 0; j < 8; ++j) { bn[j] = sx[384 + 8 * ng + j]; cn[j] = sx[448 + 8 * ng + j]; }
    float ssq = 0.f;
#pragma unroll
    for (int h = 0; h < 6; ++h) { const int hh = 6 * g + h; const float dt = DTS[b * 24 + hh], dA = __expf(-dt * __expf(a_log[hh])); const float xp = sx[64 * h + p], dx = dt * xp;
        f32x4 n0, n1; float yp = 0.f;
#pragma unroll
        for (int j = 0; j < 4; ++j) { n0[j] = dA * h0[h][0][j] + dx * bn[j]; n1[j] = dA * h0[h][1][j] + dx * bn[4 + j]; yp += cn[j] * n0[j] + cn[4 + j] * n1[j]; }
        float* op = ssm_out + ((((size_t)b * NH + hh) * 64 + p) * 64 + 8 * ng); *(f32x4*)op = n0; *(f32x4*)(op + 4) = n1;
        yp += __shfl_xor(yp, 1); yp += __shfl_xor(yp, 2); yp += __shfl_xor(yp, 4);
        const float y = (yp + d_skip[hh] * xp) * silu_f(PROJS[(size_t)b * NPROJ + PZ + 64 * hh + p]);
        if (ng == 0) { sy[64 * h + p] = y; ssq += y * y; } }
    ssq = wave_sum(ssq);
    if (F.lane == 0) sred[F.wave] = ssq;
    __syncthreads();
    float tot = 0.f;
#pragma unroll
    for (int w = 0; w < 8; ++w) tot += sred[w];
    const float rs = 1.0f / sqrtf(tot * (1.0f / 384.0f) + EPS);
    if (tid < 384) YS[(size_t)b * DMIX + 384 * g + tid] = f2bf(sy[tid] * rs * ssd_norm_w[384 * g + tid]);
    __syncthreads();
}
__device__ __forceinline__ void pool_sample_unit(const Ctx& F, float* out, int b) {
    const float* PROJS = out + OS_PROJS; bf16* YS = (bf16*)(out + OS_YS); float* pool_out = out + O_POOLS;
    LAS float* sm = (LAS float*)F.lds; const int tid = F.tid, g = F.wave >> 1, w = 2 << g;
    const float vn = PROJS[(size_t)b * NPROJ + PV + tid]; const float* sp = state_pool + (size_t)b * 15 * 512 + tid; float* po = pool_out + (size_t)b * 15 * 512 + tid;
    float s = vn;
#pragma unroll
    for (int r = 0; r < 15; ++r) { const float v = sp[r * 512]; if (r >= 15 - (w - 1)) s += v; if (r >= 1) po[(r - 1) * 512] = v; }
    po[14 * 512] = vn;
    sm[tid] = s * (1.0f / (float)w) - vn;
    __syncthreads();
    const int d = tid & 127; const float* pw = pool_w + (size_t)g * 16384 + d; float acc = 0.f;
#pragma unroll 8
    for (int c = 0; c < 128; ++c) acc += sm[128 * g + c] * pw[c * 128];
    YS[(size_t)b * DMIX + 1536 + tid] = f2bf(acc * pool_scale[tid]);
    __syncthreads();
}

__device__ __forceinline__ void s3_unit(const Ctx& F, const bf16* PROJ, const float* DT, const bf16* HIN, bf16* Y, int unit) {
    const int g = unit & 3, c = (unit >> 2) & 15, b = unit >> 6;
    conv_stage<true>(F, PROJ, b, c, g, nullptr);
    dt_stage(F, DT, b, c, g, nullptr);
    __syncthreads();
    const int i = F.lane & 15, g4 = F.lane >> 4, w = F.wave, lrow = 16 * w + i;
    const LAS bf16* xs = (const LAS bf16*)(F.lds + S_XS); const LAS bf16* Bs = (const LAS bf16*)(F.lds + S_BS); const LAS bf16* Cs = (const LAS bf16*)(F.lds + S_CS);
    const LAS float* acs = (const LAS float*)(F.lds + S_AC); const LAS float* dts = (const LAS float*)(F.lds + S_DT);
    bf16x8 Cf[2];
#pragma unroll
    for (int ks = 0; ks < 2; ++ks) Cf[ks] = *(const LAS bf16x8*)(Cs + lrow * BS + 32 * ks + 8 * g4);
    f32x4 X[8];
#pragma unroll
    for (int st = 0; st < 8; ++st) { X[st] = (f32x4){0.f, 0.f, 0.f, 0.f};
        if (st <= w) {
#pragma unroll
            for (int ks = 0; ks < 2; ++ks) { const bf16x8 a = *(const LAS bf16x8*)(Bs + (16 * st + i) * BS + 32 * ks + 8 * g4); X[st] = MFMA16(a, Cf[ks], X[st]); } } }
    const size_t grow = (size_t)b * SEQ + c * 128 + lrow;
    float mk[4], dg[4];
#pragma unroll
    for (int r = 0; r < 4; ++r) { mk[r] = (4 * g4 + r <= i) ? 1.f : 0.f; dg[r] = (4 * g4 + r == i) ? 1.f : 0.f; }
    float ssq = 0.f;
#pragma unroll 1
    for (int h = 0; h < 6; ++h) { const int hh = 6 * g + h; const float al = acs[h * 128 + lrow], Dh = d_skip[hh];
        f32x4 ya[4], yo[4];
#pragma unroll
        for (int pt = 0; pt < 4; ++pt) { ya[pt] = (f32x4){0.f, 0.f, 0.f, 0.f}; yo[pt] = (f32x4){0.f, 0.f, 0.f, 0.f}; }
#pragma unroll
        for (int u = 0; u < 4; ++u) { if (2 * u <= w) {
            float mv[8];
#pragma unroll
            for (int hf = 0; hf < 2; ++hf) { const int st = 2 * u + hf;
                if (st < w) { const f32x4 as4 = *(const LAS f32x4*)(acs + h * 128 + 16 * st + 4 * g4), dt4 = *(const LAS f32x4*)(dts + h * 128 + 16 * st + 4 * g4);
#pragma unroll
                    for (int r = 0; r < 4; ++r) mv[4 * hf + r] = X[st][r] * __expf(al - as4[r]) * dt4[r]; }
                else if (st == w) { const f32x4 as4 = *(const LAS f32x4*)(acs + h * 128 + 16 * st + 4 * g4), dt4 = *(const LAS f32x4*)(dts + h * 128 + 16 * st + 4 * g4);
#pragma unroll
                    for (int r = 0; r < 4; ++r) mv[4 * hf + r] = X[st][r] * __expf(fminf(al - as4[r], 0.f)) * dt4[r] * mk[r] + Dh * dg[r]; }
                else {
#pragma unroll
                    for (int r = 0; r < 4; ++r) mv[4 * hf + r] = 0.f; } }
            v4u pk; pk.x = cvt_pk_bf16(mv[0], mv[1]); pk.y = cvt_pk_bf16(mv[2], mv[3]); pk.z = cvt_pk_bf16(mv[4], mv[5]); pk.w = cvt_pk_bf16(mv[6], mv[7]);
            const bf16x8 mf = __builtin_bit_cast(bf16x8, pk);
#pragma unroll
            for (int pt = 0; pt < 4; ++pt) { const LAS bf16* p = xs + (32 * u + 4 * g4 + (i >> 2)) * XS + 64 * h + 16 * pt + 4 * (i & 3);
                const bf16x8 xf = cat8(tr_read(p), tr_read(p + 16 * XS)); ya[pt] = MFMA16(xf, mf, ya[pt]); } } }
        const bf16* hp = HIN + (((size_t)b * 16 + c) * 24 + hh) * 4096;
#pragma unroll
        for (int pt = 0; pt < 4; ++pt)
#pragma unroll
            for (int ks = 0; ks < 2; ++ks) { const bf16x8 hf = *(const bf16x8*)(hp + (16 * pt + i) * 64 + 32 * ks + 8 * g4); yo[pt] = MFMA16(hf, Cf[ks], yo[pt]); }
        const float el = __expf(al);
#pragma unroll
        for (int pt = 0; pt < 4; ++pt) { const s16x4 z4 = *(const s16x4*)(PROJ + grow * NPROJ + PZ + 64 * hh + 16 * pt + 4 * g4);
            float yy[4];
#pragma unroll
            for (int r = 0; r < 4; ++r) { const float y = (ya[pt][r] + el * yo[pt][r]) * silu_f(bf2f(z4[r])); yy[r] = y; ssq += y * y; }
            v2u pk; pk.x = cvt_pk_bf16(yy[0], yy[1]); pk.y = cvt_pk_bf16(yy[2], yy[3]);
            *(v2u*)(Y + grow * DMIX + 64 * hh + 16 * pt + 4 * g4) = pk; } }
    ssq += __shfl_xor(ssq, 16); ssq += __shfl_xor(ssq, 32);
    const float rs = 1.0f / sqrtf(ssq * (1.0f / 384.0f) + EPS);
    VM_WAIT();
#pragma unroll 2
    for (int hp2 = 0; hp2 < 24; ++hp2) { const int col = 384 * g + 16 * hp2 + 4 * g4; const f32x4 nw = *(const f32x4*)(ssd_norm_w + col);
        const v2u yb = *(const v2u*)(Y + grow * DMIX + col);
        v2u pk; pk.x = cvt_pk_bf16(__uint_as_float(yb.x << 16) * rs * nw[0], __uint_as_float(yb.x & 0xffff0000u) * rs * nw[1]); pk.y = cvt_pk_bf16(__uint_as_float(yb.y << 16) * rs * nw[2], __uint_as_float(yb.y & 0xffff0000u) * rs * nw[3]);
        *(v2u*)(Y + grow * DMIX + col) = pk; }
    __syncthreads();
}

struct Args { const float* in[23]; float* out; unsigned char* ws; int ph_lo, ph_hi; };
constexpr int NPHASE = 9;
#define MK_EN(k) (((MASK) >> (k)) & 1)
#ifndef MK_P2DUP
#define MK_P2DUP 0
#endif
#ifndef MK_P6DUP
#define MK_P6DUP 0
#endif
#ifndef MK_P7DUP
#define MK_P7DUP 0
#endif
#ifndef MK_P8DUP
#define MK_P8DUP 0
#endif
#ifndef MK_DUP
#define MK_DUP 0
#endif
#define MK_DUPK(k) (((MK_DUP) >> (k)) & 1)

template <int MASK> __global__ void __launch_bounds__(NT, 2) mk_fwd(Args args) {
    extern __shared__ __attribute__((aligned(16))) unsigned char lds_raw[];
    Ctx F;
    F.lds = (LAS unsigned char*)lds_raw;
    F.wave = __builtin_amdgcn_readfirstlane(threadIdx.x >> 6);
#define REFRESH() do { F.lane = lane_now(); F.tid = F.wave * 64 + F.lane; } while (0)
    REFRESH();
    F.G = gridDim.x; { const int bx = blockIdx.x; F.vcu = (F.G % 8 == 0) ? (bx % 8) * (F.G / 8) + bx / 8 : bx; }
    volatile LAS unsigned* MISC = (volatile LAS unsigned*)(F.lds + MISC_OFF);
    if (F.tid < 128) MISC[F.tid] = 0u;
    __syncthreads();
    unsigned char* ws = args.ws; float* out = args.out;
    unsigned* ctl = (unsigned*)(ws + WS_CTL);
    const int lo = args.ph_lo, hi = args.ph_hi;
    XcdBarrier bar; bar.bar = ctl + CW_BAR; bar.x = 0; bar.st = nullptr;
    if (hi - lo > 1) bar = xcd_barrier_post(ctl + CW_BAR, MISC + 8, F.tid == 0);
#define IN(k) (lo <= (k) && (k) < hi)
#define SEAM(k) do { REFRESH(); if (IN(k) && IN((k) + 1)) xcd_barrier(bar, F.tid == 0); REFRESH(); } while (0)
    bf16* Win_t = (bf16*)(ws + WS_WIN); bf16* Wout_t = (bf16*)(ws + WS_WOUT); bf16* Wup_t = (bf16*)(ws + WS_WUP); bf16* Wdn_t = (bf16*)(ws + WS_WDN);
    bf16* Wdt_t = (bf16*)(ws + WS_WDT); bf16* PWt = (bf16*)(ws + WS_PWT);
    bf16* XN1 = (bf16*)(ws + WS_A); bf16* HIN = (bf16*)(ws + WS_A); bf16* X1b = (bf16*)(ws + WS_A);
    bf16* PROJ = (bf16*)(ws + WS_B); bf16* Hb = (bf16*)(ws + WS_B + WB_H); float* UT = (float*)(ws + WS_B + WB_UT); float* UH = (float*)(ws + WS_B + WB_UH);
    float* SSP = (float*)(ws + WS_B + WB_SSP); float* SSP2 = (float*)(ws + WS_B + WB_SSP2); bf16* HS = (bf16*)(ws + WS_B + WB_HS); float* X2S = (float*)(ws + WS_B + WB_X2S);
    bf16* Y = (bf16*)(ws + WS_Y); float* DT = (float*)(ws + WS_DT); float* CDEC = (float*)(ws + WS_CDEC);
    float* X1S = (float*)(ws + WS_X1S); bf16* XN2S = (bf16*)(ws + WS_XN2S); bf16* XN1S = (bf16*)(ws + WS_XN1S);
    float* PROJS = out + OS_PROJS; float* DTS = out + OS_DTS; bf16* YS = (bf16*)(out + OS_YS);
    float* CS = out + O_YP;
    float* X1 = out + O_YP;
    const int gw = F.vcu * NWAVES + F.wave, NGW = F.G * NWAVES;
    LAS float* redl = (LAS float*)F.lds;

    if (IN(0) && MK_EN(0)) for (int rep_ = 0; rep_ <= MK_DUPK(0); ++rep_) { if (rep_) { REFRESH(); xcd_barrier(bar, F.tid == 0); REFRESH(); }
        LAS float* scr = (LAS float*)(F.lds + F.wave * 16384);
        constexpr int I1 = 16 * 112, I2 = 16 * 16, I3 = 32 * 32, I4 = 16 * 176, I5 = 44 * 32, I6 = 32, I7 = 16, NITEMS = I1 + I2 + I3 + I4 + I5 + I6 + I7;
        for (int it = gw; it < NITEMS; it += NGW) {
            int r = it;
            if (r < I1) { transpose_item(w_in, INC, 64 * (r / 112), 32 * (r % 112), 32, Win_t, 1024, 32 * (r % 112), nullptr, scr, F.lane); continue; } r -= I1;
            if (r < I2) { transpose_item(w_in, INC, 64 * (r / 16), 3608 + 32 * (r % 16), 32, Win_t, 1024, 3584 + 32 * (r % 16), nullptr, scr, F.lane); continue; } r -= I2;
            if (r < I3) { transpose_item(w_out, 1024, 64 * (r / 32), 32 * (r % 32), 32, Wout_t, 2048, 32 * (r % 32), nullptr, scr, F.lane); continue; } r -= I3;
            if (r < I4) { const int j = 32 * (r % 176); const int drow = (j < DFF) ? 256 * (j / 128) + (j % 128) : 256 * ((j - DFF) / 128) + 128 + ((j - DFF) % 128);
                          transpose_item(w_up, UPN, 64 * (r / 176), j, 32, Wup_t, 1024, drow, norm2_w, scr, F.lane); continue; } r -= I4;
            if (r < I5) { transpose_item(w_down, 1024, 64 * (r / 32), 32 * (r % 32), 32, Wdn_t, DFF, 32 * (r % 32), nullptr, scr, F.lane); continue; } r -= I5;
            if (r < I6) { const int g = r >> 3, rr = r & 7; transpose_item(pool_w + (size_t)g * 16384, 128, 64 * (rr >> 2), 32 * (rr & 3), 32, PWt + (size_t)g * 16384, 128, 32 * (rr & 3), nullptr, scr, F.lane); continue; } r -= I6;
            transpose_item(w_in, INC, 64 * r, 3584, 24, Wdt_t, 1024, 0, nullptr, scr, F.lane);
        }
        { float* fcw = (float*)(ws + WS_FCW);
          for (int j = F.vcu * NT + F.tid; j < 4 * UPN; j += F.G * NT) fcw[j] = (j < 3 * UPN) ? ffn_conv_w[j] : ffn_conv_b[j - 3 * UPN]; }
        for (int m = gw; m < MP + NS; m += NGW) {
            if (m < MP) rms_row_to_bf16(x_prompt + (size_t)m * DM, norm1_w, XN1 + (size_t)m * DM, F.lane);
            else rms_row_to_bf16(x_sample + (size_t)(m - MP) * DM, norm1_w, XN1S + (size_t)(m - MP) * DM, F.lane);
        }
        __syncthreads();
    }
    SEAM(0);

    if (IN(1) && MK_EN(1)) for (int rep_ = 0; rep_ <= MK_DUPK(1); ++rep_) { if (rep_) { REFRESH(); xcd_barrier(bar, F.tid == 0); REFRESH(); }
        const int i = F.lane & 15, g4 = F.lane >> 4;
        for (int blk = F.vcu; blk < MP / 64; blk += F.G) {
            const int mt = F.wave >> 1, nt = F.wave & 1;
            const bf16* ap = XN1 + (size_t)(blk * 64 + mt * 16 + i) * DM + 8 * g4; const bf16* bp = Wdt_t + (size_t)(nt * 16 + i) * DM + 8 * g4;
            f32x4 acc = (f32x4){0.f, 0.f, 0.f, 0.f};
#pragma unroll 8
            for (int ks = 0; ks < 32; ++ks) acc = MFMA16(*(const bf16x8*)(ap + 32 * ks), *(const bf16x8*)(bp + 32 * ks), acc);
            const int h = nt * 16 + i;
            if (h < NH) { const float bias = dt_bias[h];
#pragma unroll
                for (int r = 0; r < 4; ++r) DT[(size_t)(blk * 64 + mt * 16 + 4 * g4 + r) * 24 + h] = softplus_f(acc[r] + bias); }
        }
        for (int sl = F.vcu; sl < 256 + 2; sl += F.G) {
            f32x4 acc[8];
            const bool isdt = sl >= 256; const int n0 = isdt ? 16 * (sl - 256) : 16 * sl;
            skinny_acc<8, 1024>(XN1S, isdt ? Wdt_t : Win_t, 0, n0, F.wave, F.lane, acc);
            const f32x4 s = skinny_reduce<8>(redl, acc, F.wave, F.lane, F.tid);
            const int col = n0 + (F.tid & 15), rowb = 16 * (F.tid >> 6) + 4 * ((F.tid & 63) >> 4);
            if (!isdt) {
#pragma unroll
                for (int r = 0; r < 4; ++r) PROJS[(size_t)(rowb + r) * NPROJ + col] = s[r]; }
            else if (col < NH) { const float bias = dt_bias[col];
#pragma unroll
                for (int r = 0; r < 4; ++r) DTS[(rowb + r) * 24 + col] = softplus_f(s[r] + bias); }
        }
        __syncthreads();
        pg8::Gemm gm{XN1, Win_t, MP, NPROJ, DM}; pg8::StaticOrder S; S.init(MP, NPROJ, F.G, (int)blockIdx.x);
        pg8::EpiStoreBf16 E{PROJ, NPROJ};
        pg8::gemm_phase<pg8::EpiStoreBf16, pg8::StaticOrder, true, true>(F.lds + RING_OFF, gm, S, E, F.tid);
    }
    SEAM(1);

    if (IN(2) && MK_EN(2)) for (int rep_ = 0; rep_ <= MK_DUPK(2); ++rep_) { if (rep_) { REFRESH(); xcd_barrier(bar, F.tid == 0); REFRESH(); }
        constexpr int NU0 = 512 + 512 + 512 + 128, NUX = ((MK_P2DUP & 1) ? 512 : 0) + ((MK_P2DUP & 2) ? 512 : 0) + ((MK_P2DUP & 4) ? 512 : 0) + ((MK_P2DUP & 8) ? 128 : 0);
        for (int u0 = F.vcu; u0 < NU0 + NUX; u0 += F.G) {
            int u = u0;
            if (u >= NU0) u = (MK_P2DUP & 1) ? u - NU0 : (MK_P2DUP & 2) ? u - NU0 + 512 : (MK_P2DUP & 4) ? u - NU0 + 1024 : u - NU0 + 1536;
            if (u < 512) s1_unit(F, PROJ, DT, CS, CDEC, out + O_CONVP, u);
            else if (u < 1024) pool_unit(F, PROJ, PWt, Y, out + O_POOLP, u - 512);
            else if (u < 1536) ssm_sample_unit(F, out, u - 1024);
            else pool_sample_unit(F, out, u - 1536);
        }
    }
    SEAM(2);

    if (IN(3) && MK_EN(3)) for (int rep_ = 0; rep_ <= MK_DUPK(3); ++rep_) { if (rep_) { REFRESH(); xcd_barrier(bar, F.tid == 0); REFRESH(); }
        for (int it = F.vcu * NT + F.tid; it < NB * NH * 64 * 16; it += F.G * NT) {
            const int n4 = it & 15, p = (it >> 4) & 63, hh = (it >> 10) % NH, b = (it >> 10) / NH;
            f32x4 cs[16];
#pragma unroll
            for (int c = 0; c < 16; ++c) cs[c] = *(const f32x4*)(CS + ((((size_t)b * 16 + c) * NH + hh) * 64 + p) * 64 + 4 * n4);
            f32x4 h = (f32x4){0.f, 0.f, 0.f, 0.f};
#pragma unroll
            for (int c = 0; c < 16; ++c) { v2u pk; pk.x = cvt_pk_bf16(h[0], h[1]); pk.y = cvt_pk_bf16(h[2], h[3]);
                *(v2u*)(HIN + ((((size_t)b * 16 + c) * NH + hh) * 64 + p) * 64 + 4 * n4) = pk;
                h = h * CDEC[(b * 16 + c) * NH + hh] + cs[c]; }
            *(f32x4*)(out + O_SSMP + (((size_t)b * NH + hh) * 64 + p) * 64 + 4 * n4) = h;
        }
        for (int sl = F.vcu; sl < 256; sl += F.G) {
            const int rt = sl >> 6, nt = sl & 63; f32x4 acc[2];
            skinny_acc<2, 2048>(YS, Wout_t, 32 * rt, 16 * nt, F.wave, F.lane, acc);
            const f32x4 s = skinny_reduce<2>(redl, acc, F.wave, F.lane, F.tid);
            if ((F.tid >> 6) < 2) { const int col = 16 * nt + (F.tid & 15), rowb = 32 * rt + 16 * (F.tid >> 6) + 4 * ((F.tid & 63) >> 4);
#pragma unroll
                for (int r = 0; r < 4; ++r) X1S[(size_t)(rowb + r) * DM + col] = s[r] + x_sample[(size_t)(rowb + r) * DM + col]; }
        }
    }
    SEAM(3);

    if (IN(4) && MK_EN(4)) for (int rep_ = 0; rep_ <= MK_DUPK(4); ++rep_) { if (rep_) { REFRESH(); xcd_barrier(bar, F.tid == 0); REFRESH(); }
        for (int u = F.vcu; u < 512; u += F.G) s3_unit(F, PROJ, DT, HIN, Y, u);
        for (int m = gw; m < NS; m += NGW) rms_row_to_bf16(X1S + (size_t)m * DM, nullptr, XN2S + (size_t)m * DM, F.lane);
    }
    SEAM(4);

    if (IN(5) && MK_EN(5)) for (int rep_ = 0; rep_ <= MK_DUPK(5); ++rep_) { if (rep_) { REFRESH(); xcd_barrier(bar, F.tid == 0); REFRESH(); }
        for (int sl = F.vcu; sl < 352; sl += F.G) {
            const int rt = sl / 176, ct = sl % 176, c0 = 16 * ct, ng0 = 256 * (c0 >> 7) + (c0 & 127);
            f32x4 acc[4];
            skinny_acc<4, 1024>(XN2S, Wup_t, 64 * rt, ng0, F.wave, F.lane, acc);
            const f32x4 sg = skinny_reduce<4>(redl, acc, F.wave, F.lane, F.tid);
            skinny_acc<4, 1024>(XN2S, Wup_t, 64 * rt, ng0 + 128, F.wave, F.lane, acc);
            const f32x4 sv = skinny_reduce<4>(redl, acc, F.wave, F.lane, F.tid);
            if ((F.tid >> 6) < 4) { const int ch = c0 + (F.tid & 15), rowb = 64 * rt + 16 * (F.tid >> 6) + 4 * ((F.tid & 63) >> 4);
                const float wg0 = ffn_conv_w[ch], wg1 = ffn_conv_w[UPN + ch], wg2 = ffn_conv_w[2 * UPN + ch], bg = ffn_conv_b[ch];
                const float wv0 = ffn_conv_w[DFF + ch], wv1 = ffn_conv_w[UPN + DFF + ch], wv2 = ffn_conv_w[2 * UPN + DFF + ch], bv = ffn_conv_b[DFF + ch];
#pragma unroll
                for (int r = 0; r < 4; ++r) { const int bb = rowb + r; const float* st = state_ffn + (size_t)bb * 2 * UPN; float* fo = out + O_FFNS + (size_t)bb * 2 * UPN;
                    const float g0 = st[ch], g1 = st[UPN + ch], v0 = st[DFF + ch], v1 = st[UPN + DFF + ch];
                    const float ug = bg + wg0 * g0 + wg1 * g1 + wg2 * sg[r], uv = bv + wv0 * v0 + wv1 * v1 + wv2 * sv[r];
                    HS[(size_t)bb * DFF + ch] = f2bf(silu_f(ug) * uv);
                    fo[ch] = g1; fo[UPN + ch] = sg[r]; fo[DFF + ch] = v1; fo[UPN + DFF + ch] = sv[r]; } }
        }
        __syncthreads();
        pg8::Gemm gm{Y, Wout_t, MP, DM, DMIX}; pg8::StaticOrder S; S.init(MP, DM, F.G, (int)blockIdx.x);
        pg8::EpiResid<true> E{x_prompt, X1, X1b, SSP};
        pg8::gemm_phase<pg8::EpiResid<true>, pg8::StaticOrder, true, true>(F.lds + RING_OFF, gm, S, E, F.tid);
    }
    SEAM(5);

    if (IN(6) && MK_EN(6)) for (int rep_ = 0; rep_ <= MK_DUPK(6); ++rep_) { if (rep_) { REFRESH(); xcd_barrier(bar, F.tid == 0); REFRESH(); }
        for (int sl = F.vcu; sl < 256; sl += F.G) {
            const int rt = sl >> 6, nt = sl & 63; f32x4 acc[2];
            skinny_acc<2, 2816>(HS, Wdn_t, 32 * rt, 16 * nt, F.wave, F.lane, acc);
            const f32x4 s = skinny_reduce<2>(redl, acc, F.wave, F.lane, F.tid);
            if ((F.tid >> 6) < 2) { const int col = 16 * nt + (F.tid & 15), rowb = 32 * rt + 16 * (F.tid >> 6) + 4 * ((F.tid & 63) >> 4);
#pragma unroll
                for (int r = 0; r < 4; ++r) X2S[(size_t)(rowb + r) * DM + col] = s[r] + X1S[(size_t)(rowb + r) * DM + col]; }
        }
        __syncthreads();
        pg8::Gemm gm{X1b, Wup_t, MP, UPN, DM}; pg8::UpOrder S; S.init(MP, UPN, F.G, (int)blockIdx.x);
        S.fcw = (const float*)(ws + WS_FCW); S.lds = F.lds; S.wid = F.wave; S.k_ = 0;
        { pg8::Unit u; LAS float* RS = (LAS float*)(F.lds + pg8::UP_RS);
          for (int ui = 0; ui < 8 && S.next(ui, u); ++ui)
              for (int r = F.tid; r < 256; r += NT) { const f32x4* pp = (const f32x4*)(SSP + (size_t)(u.pm * 256 + r) * 16); const f32x4 p0 = pp[0], p1 = pp[1], p2 = pp[2], p3 = pp[3];
                  const float sq = ((p0[0] + p0[1]) + (p0[2] + p0[3])) + ((p1[0] + p1[1]) + (p1[2] + p1[3])) + ((p2[0] + p2[1]) + (p2[2] + p2[3])) + ((p3[0] + p3[1]) + (p3[2] + p3[3]));
                  RS[ui * 256 + r] = __builtin_amdgcn_rsqf(sq * (1.0f / 1024.0f) + EPS); } }
        __syncthreads();
#if MK_P6DUP
        { pg8::StaticOrder S0; S0.init(MP, UPN, F.G, (int)blockIdx.x); pg8::EpiNull E0{(float*)(ws + WS_Y)};
          pg8::gemm_phase<pg8::EpiNull, pg8::StaticOrder, true, true>(F.lds + RING_OFF, gm, S0, E0, F.tid); REFRESH(); xcd_barrier(bar, F.tid == 0); REFRESH(); }
#endif
        typedef pg8::EpiUp<WS_B + WB_H, WS_B + WB_UT, WS_B + WB_UH> EpiUpT;
        EpiUpT E{ws, out + O_FFNP, F.lds, 0};
        pg8::gemm_phase<EpiUpT, pg8::UpOrder, true, true>(F.lds + RING_OFF, gm, S, E, F.tid);
    }
    SEAM(6);

    if (IN(7) && MK_EN(7)) for (int rep_ = 0; rep_ <= MK_DUPK(7); ++rep_) { if (rep_) { REFRESH(); xcd_barrier(bar, F.tid == 0); REFRESH(); }
        for (int m = gw; m < NS; m += NGW) {
            const f32x4* xr = (const f32x4*)(X2S + (size_t)m * DM) + F.lane; f32x4 v[4]; float s = 0.f;
#pragma unroll
            for (int j = 0; j < 4; ++j) { v[j] = xr[64 * j]; s += (v[j][0] * v[j][0] + v[j][1] * v[j][1]) + (v[j][2] * v[j][2] + v[j][3] * v[j][3]); }
            const float rs = 1.0f / sqrtf(wave_sum(s) * (1.0f / 1024.0f) + EPS);
            f32x4* yo = (f32x4*)(out + O_YS + (size_t)m * DM) + F.lane;
#pragma unroll
            for (int j = 0; j < 4; ++j) yo[64 * j] = v[j] * rs * ((const f32x4*)final_norm_w)[F.lane + 64 * j];
        }
        pg8::StaticOrder S; S.init(MP, DM, F.G, (int)blockIdx.x);
        { pg8::Unit u;
          for (int ui = 0; S.next(ui, u); ++ui) { const int pm = u.pm; if ((pm & 7) == 0) continue;
            for (int j = F.tid; j < DFF; j += NT) { const int gi = 256 * (j >> 7) + (j & 127), vi = gi + 128;
                const float* t0 = UT + (size_t)(pm - 1) * 2 * UPN; const float* h0 = UH + (size_t)pm * 2 * UPN;
                const float gm2 = t0[gi], gm1 = t0[UPN + gi], g0 = h0[gi], g1 = h0[UPN + gi];
                const float vm2 = t0[vi], vm1 = t0[UPN + vi], v0 = h0[vi], v1 = h0[UPN + vi];
                const float wg0 = ffn_conv_w[j], wg1 = ffn_conv_w[UPN + j], wg2 = ffn_conv_w[2 * UPN + j], bg = ffn_conv_b[j];
                const float wv0 = ffn_conv_w[DFF + j], wv1 = ffn_conv_w[UPN + DFF + j], wv2 = ffn_conv_w[2 * UPN + DFF + j], bv = ffn_conv_b[DFF + j];
                const float ug0 = bg + wg0 * gm2 + wg1 * gm1 + wg2 * g0, ug1 = bg + wg0 * gm1 + wg1 * g0 + wg2 * g1;
                const float uv0 = bv + wv0 * vm2 + wv1 * vm1 + wv2 * v0, uv1 = bv + wv0 * vm1 + wv1 * v0 + wv2 * v1;
                Hb[(size_t)(256 * pm) * DFF + j] = f2bf(silu_f(ug0) * uv0); Hb[(size_t)(256 * pm + 1) * DFF + j] = f2bf(silu_f(ug1) * uv1); } } }
        VM_WAIT(); __syncthreads();
        pg8::Gemm gm{Hb, Wdn_t, MP, DM, DFF};
#if MK_P7DUP
        { pg8::EpiResid<false> E0{X1, (float*)(ws + WS_Y), nullptr, SSP2}; pg8::gemm_phase<pg8::EpiResid<false>, pg8::StaticOrder, true, true>(F.lds + RING_OFF, gm, S, E0, F.tid); REFRESH(); xcd_barrier(bar, F.tid == 0); REFRESH(); }
#endif
        pg8::EpiResid<false> E{X1, X1, nullptr, SSP2};
        pg8::gemm_phase<pg8::EpiResid<false>, pg8::StaticOrder, true, true>(F.lds + RING_OFF, gm, S, E, F.tid);
    }
    SEAM(7);

    if (IN(8) && MK_EN(8)) for (int rep_ = 0; rep_ <= MK_DUPK(8); ++rep_) { if (rep_) { REFRESH(); xcd_barrier(bar, F.tid == 0); REFRESH(); }
#if MK_P8DUP
        for (int m = gw; m < MP; m += NGW) {
            f32x4* xr = (f32x4*)(out + O_YP + (size_t)m * DM) + F.lane; f32x4* xw = (f32x4*)((float*)(ws + WS_Y) + (size_t)m * DM) + F.lane; f32x4 v[4];
#pragma unroll
            for (int j = 0; j < 4; ++j) v[j] = xr[64 * j];
            const f32x4* pp = (const f32x4*)(SSP2 + (size_t)m * 16); const f32x4 p0 = pp[0], p1 = pp[1], p2 = pp[2], p3 = pp[3];
            const float s = ((p0[0] + p0[1]) + (p0[2] + p0[3])) + ((p1[0] + p1[1]) + (p1[2] + p1[3])) + ((p2[0] + p2[1]) + (p2[2] + p2[3])) + ((p3[0] + p3[1]) + (p3[2] + p3[3]));
            const float rs = 1.0f / sqrtf(s * (1.0f / 1024.0f) + EPS);
#pragma unroll
            for (int j = 0; j < 4; ++j) xw[64 * j] = v[j] * rs * ((const f32x4*)final_norm_w)[F.lane + 64 * j];
        }
        REFRESH(); xcd_barrier(bar, F.tid == 0); REFRESH();
#endif
        for (int m = gw; m < MP; m += NGW) {
            f32x4* xr = (f32x4*)(out + O_YP + (size_t)m * DM) + F.lane; f32x4 v[4];
#pragma unroll
            for (int j = 0; j < 4; ++j) v[j] = xr[64 * j];
            const f32x4* pp = (const f32x4*)(SSP2 + (size_t)m * 16); const f32x4 p0 = pp[0], p1 = pp[1], p2 = pp[2], p3 = pp[3];
            const float s = ((p0[0] + p0[1]) + (p0[2] + p0[3])) + ((p1[0] + p1[1]) + (p1[2] + p1[3])) + ((p2[0] + p2[1]) + (p2[2] + p2[3])) + ((p3[0] + p3[1]) + (p3[2] + p3[3]));
            const float rs = 1.0f / sqrtf(s * (1.0f / 1024.0f) + EPS);
#pragma unroll
            for (int j = 0; j < 4; ++j) xr[64 * j] = v[j] * rs * ((const f32x4*)final_norm_w)[F.lane + 64 * j];
        }
    }
#undef IN
#undef SEAM
}
#undef x_prompt
#undef x_sample
#undef state_ssm
#undef state_conv
#undef state_pool
#undef state_ffn
#undef norm1_w
#undef w_in
#undef conv_w
#undef conv_b
#undef dt_bias
#undef a_log
#undef d_skip
#undef ssd_norm_w
#undef pool_w
#undef pool_scale
#undef w_out
#undef norm2_w
#undef w_up
#undef ffn_conv_w
#undef ffn_conv_b
#undef w_down
#undef final_norm_w
}

#ifndef MK_PER_PHASE
#define MK_PER_PHASE 0
#endif
extern "C" void kernel_launch(void* const* d_in, const int* in_sizes, int n_in, void* d_out, int out_size, void* d_ws, size_t ws_size, hipStream_t stream) {
    using namespace mk;
    static int grid = 0;
    if (grid == 0) {
        if (n_in != 23 || in_sizes[0] != MP * DM || out_size != (int)O_END || ws_size < WS_END) {
            fprintf(stderr, "kernel_launch: unexpected problem (n_in %d, in0 %d, out %d, ws %zu); nothing launched\n", n_in, n_in > 0 ? in_sizes[0] : -1, out_size, ws_size); grid = -1; return; }
        int dev = 0, cus = 0, per_cu = 0;
        if (hipGetDevice(&dev) != hipSuccess || hipDeviceGetAttribute(&cus, hipDeviceAttributeMultiprocessorCount, dev) != hipSuccess) { fprintf(stderr, "kernel_launch: device query failed\n"); grid = -1; return; }
#if MK_PER_PHASE
        const void* fns[9] = {(const void*)mk_fwd<1>, (const void*)mk_fwd<2>, (const void*)mk_fwd<4>, (const void*)mk_fwd<8>, (const void*)mk_fwd<16>, (const void*)mk_fwd<32>, (const void*)mk_fwd<64>, (const void*)mk_fwd<128>, (const void*)mk_fwd<256>};
        const int nfn = 9;
#else
        const void* fns[1] = {(const void*)mk_fwd<0x1FF>};
        const int nfn = 1;
#endif
        for (int i = 0; i < nfn; ++i)
            if (hipFuncSetAttribute(fns[i], hipFuncAttributeMaxDynamicSharedMemorySize, LDS_BYTES) != hipSuccess) { fprintf(stderr, "kernel_launch: hipFuncSetAttribute(%d B LDS) failed\n", LDS_BYTES); grid = -1; return; }
        if (hipOccupancyMaxActiveBlocksPerMultiprocessor(&per_cu, fns[0], NT, LDS_BYTES) != hipSuccess || per_cu < 1) {
            fprintf(stderr, "kernel_launch: occupancy query reports %d workgroups per CU; nothing launched\n", per_cu); (void)hipGetLastError(); grid = -1; return; }
        grid = cus;
    }
    if (grid < 0) return;
    if (hipMemsetAsync((char*)d_ws + WS_CTL, 0, CTL_BYTES, stream) != hipSuccess) { fprintf(stderr, "kernel_launch: memset failed\n"); return; }
    Args a{};
    for (int i = 0; i < 23; ++i) a.in[i] = (const float*)d_in[i];
    a.out = (float*)d_out; a.ws = (unsigned char*)d_ws;
#if MK_PER_PHASE
#define MK_LAUNCH(p) do { a.ph_lo = p; a.ph_hi = p + 1; hipLaunchKernelGGL(mk_fwd<(1 << p)>, dim3(grid), dim3(NT), LDS_BYTES, stream, a); } while (0)
    MK_LAUNCH(0); MK_LAUNCH(1); MK_LAUNCH(2); MK_LAUNCH(3); MK_LAUNCH(4); MK_LAUNCH(5); MK_LAUNCH(6); MK_LAUNCH(7); MK_LAUNCH(8);
#else
    a.ph_lo = 0; a.ph_hi = NPHASE;
    hipLaunchKernelGGL(mk_fwd<0x1FF>, dim3(grid), dim3(NT), LDS_BYTES, stream, a);
#endif
    const hipError_t le = hipPeekAtLastError();
    if (le != hipSuccess) fprintf(stderr, "kernel_launch: launch failed: %s\n", hipGetErrorName(le));
}
```

```cpp
#include <hip/hip_runtime.h>
#include <cstdio>
#include <cstdint>
namespace pg8 {
#define PG8_LAS __attribute__((address_space(3)))
typedef unsigned short bf16_t;
typedef short bf16x8 __attribute__((ext_vector_type(8)));
typedef float f32x4 __attribute__((ext_vector_type(4)));
typedef unsigned u32x4 __attribute__((ext_vector_type(4)));
constexpr int BM = 256, BK = 64, HALF = 128, HTB = HALF * BK * 2  , STAGE_BYTES = 8 * HTB, NXCD = 8, WGM = 8;

__host__ __device__ __forceinline__ int lds_byte(int r, int c) { const int st = (r >> 4) * 2 + (c >> 5), rr = r & 15, cc = c & 31, ob = rr * 64 + cc * 2; return st * 1024 + (ob ^ (((ob >> 9) & 1) << 5)); }
__host__ __device__ __forceinline__ void stage_rc(int b, int& R, int& C) { const int st = b / 1024, sb = b % 1024, swz = sb ^ (((sb >> 9) & 1) << 5); R = (st >> 1) * 16 + swz / 64; C = (st & 1) * 32 + (swz % 64) / 2; }
__host__ __device__ __forceinline__ int perm32(int rho) { const int n = rho >> 4, i = rho & 15; return 8 * (i >> 2) + 4 * n + (i & 3); }

struct Unit { int pm, pn; };
struct Gemm { const bf16_t* A; const bf16_t* Bt; int M, N, K; };

struct StaticOrder {
    int nM, nN, nwg, G, c;
    __host__ __device__ void init(int M, int N, int G_, int c_) { nM = M / BM; nN = N / BM; nwg = nM * nN; G = G_; c = c_; }
    __host__ __device__ bool next(int i, Unit& u) const {
        const long L = (long)i * G + c; if (L >= nwg) return false;
        int wgid = (int)L; { const int q = nwg / NXCD, r = nwg % NXCD, xcd = wgid % NXCD, off = wgid / NXCD; wgid = (xcd < r ? xcd * (q + 1) : r * (q + 1) + (xcd - r) * q) + off; }
        const int nig = WGM * nN, gid = wgid / nig, fm = gid * WGM, gsz = (nM - fm) < WGM ? (nM - fm) : WGM;
        u.pm = fm + ((wgid % nig) % gsz); u.pn = (wgid % nig) / gsz; return true;
    }
    __device__ __forceinline__ void a_ready(const Unit&) const {}
    __device__ __forceinline__ void done(const Unit&) const {}
};

__device__ __forceinline__ unsigned cvt_pk_bf16(float lo, float hi) { unsigned r; asm volatile("v_cvt_pk_bf16_f32 %0, %1, %2" : "=v"(r) : "v"(lo), "v"(hi)); return r; }
typedef float f32x2 __attribute__((ext_vector_type(2)));
typedef unsigned u32x2 __attribute__((ext_vector_type(2)));
__device__ __forceinline__ float silu_f(float x) { return x * __builtin_amdgcn_rcpf(1.0f + __expf(-x)); }
__device__ __forceinline__ float dpp_ror1(float v) { return __builtin_bit_cast(float, __builtin_amdgcn_update_dpp(0, __builtin_bit_cast(int, v), 0x121, 0xf, 0xf, false)); }
__device__ __forceinline__ float dpp_ror2(float v) { return __builtin_bit_cast(float, __builtin_amdgcn_update_dpp(0, __builtin_bit_cast(int, v), 0x122, 0xf, 0xf, false)); }

struct EpiStoreBf16 {
    static constexpr bool PERM = true, AFTER_DRAIN = false;
    bf16_t* O; int ldc;
    __device__ __forceinline__ void operator()(f32x4 (&acc)[2][2][4][2], const Unit& u, int wr, int wc, int fr, int fq) const {
        const int row0 = u.pm * BM + wr * 64 + fr, col0 = u.pn * BM + wc * 32 + 8 * fq;
#pragma unroll
        for (int ai = 0; ai < 2; ++ai)
#pragma unroll
            for (int m = 0; m < 4; ++m) { bf16_t* rowp = O + (size_t)(row0 + ai * HALF + m * 16) * ldc + col0;
#pragma unroll
                for (int bj = 0; bj < 2; ++bj) { const f32x4 v0 = acc[ai][bj][m][0], v1 = acc[ai][bj][m][1];
                    u32x4 w; w.x = cvt_pk_bf16(v0[0], v0[1]); w.y = cvt_pk_bf16(v0[2], v0[3]); w.z = cvt_pk_bf16(v1[0], v1[1]); w.w = cvt_pk_bf16(v1[2], v1[3]);
                    *(u32x4*)(rowp + bj * HALF) = w; } }
    }
};

template <bool WITH_BF16> struct EpiResid {
    static constexpr bool PERM = false, AFTER_DRAIN = false;
    const float* xin; float* xo; bf16_t* xb; float* ssp;
    __device__ __forceinline__ void operator()(f32x4 (&acc)[2][2][4][2], const Unit& u, int wr, int wc, int fr, int fq) const {
        const int row0 = u.pm * BM + wr * 64 + fr, col0 = u.pn * BM + wc * 32 + 4 * fq;
#pragma unroll
        for (int ai = 0; ai < 2; ++ai)
#pragma unroll
            for (int m = 0; m < 4; ++m) { const int row = row0 + ai * HALF + m * 16; float ss = 0.f;
#pragma unroll
                for (int bj = 0; bj < 2; ++bj)
#pragma unroll
                    for (int n = 0; n < 2; ++n) { const size_t off = (size_t)row * 1024 + col0 + bj * HALF + n * 16;
                        const f32x4 v = acc[ai][bj][m][n] + *(const f32x4*)(xin + off);
                        *(f32x4*)(xo + off) = v; ss += (v[0] * v[0] + v[1] * v[1]) + (v[2] * v[2] + v[3] * v[3]);
                        if (WITH_BF16) { u32x2 w; w.x = cvt_pk_bf16(v[0], v[1]); w.y = cvt_pk_bf16(v[2], v[3]); *(u32x2*)(xb + off) = w; } }
                ss += __shfl_xor(ss, 16); ss += __shfl_xor(ss, 32);
                if (fq == 0) ssp[(size_t)row * 16 + u.pn * 4 + wc] = ss; }
    }
};

struct EpiNull {
    static constexpr bool PERM = true, AFTER_DRAIN = false; float* dummy;
    __device__ __forceinline__ void operator()(f32x4 (&acc)[2][2][4][2], const Unit& u, int wr, int wc, int fr, int fq) const {
        f32x4 s = (f32x4){0.f, 0.f, 0.f, 0.f};
#pragma unroll
        for (int ai = 0; ai < 2; ++ai)
#pragma unroll
            for (int bj = 0; bj < 2; ++bj)
#pragma unroll
                for (int m = 0; m < 4; ++m)
#pragma unroll
                    for (int n = 0; n < 2; ++n) s += acc[ai][bj][m][n];
        dummy[(size_t)(u.pm * 22 + u.pn) * 512 + (wr * 4 + wc) * 64 + fq * 16 + fr] = (s[0] + s[1]) + (s[2] + s[3]);
    }
};
constexpr int UP_EX = 131072, UP_WB = UP_EX + 8192, UP_RS = UP_WB + 8192;
struct UpOrder : StaticOrder {
    const float* fcw; PG8_LAS unsigned char* lds; int wid; mutable int k_;
    __device__ __forceinline__ void a_ready(const Unit& u) const {
        if (wid < 4) { int l; asm volatile("v_mbcnt_lo_u32_b32 %0, -1, 0\n\tv_mbcnt_hi_u32_b32 %0, -1, %0" : "=v"(l));
            const int col = (l < 32) ? 128 * u.pn + 4 * l : 2816 + 128 * u.pn + 4 * (l - 32);
            __builtin_amdgcn_global_load_lds((const unsigned*)(fcw + wid * 5632 + col), (PG8_LAS unsigned*)(lds + UP_WB + (k_ & 1) * 4096 + wid * 1024), 16, 0, 0); }
        ++k_;
    }
};
template <size_t OFF_H, size_t OFF_UT, size_t OFF_UH> struct EpiUp {
    static constexpr bool PERM = true, AFTER_DRAIN = false;
    unsigned char* ws; float* ffn_out; PG8_LAS unsigned char* lds; mutable int ui_;
    __device__ __forceinline__ void operator()(f32x4 (&acc)[2][2][4][2], const Unit& u, int wr, int wc, int fr_, int fq_) const {
        int t_; asm volatile("v_mbcnt_lo_u32_b32 %0, -1, 0\n\tv_mbcnt_hi_u32_b32 %0, -1, %0" : "=v"(t_)); const int fr = t_ & 15, fq = (t_ >> 4) & 3;
        bf16_t* H = (bf16_t*)(ws + OFF_H); float* UT = (float*)(ws + OFF_UT); float* UH = (float*)(ws + OFF_UH);
        PG8_LAS float* ex = (PG8_LAS float*)(lds + UP_EX); const PG8_LAS float* W = (const PG8_LAS float*)(lds + UP_WB + (ui_ & 1) * 4096); const PG8_LAS float* RS = (const PG8_LAS float*)(lds + UP_RS + ui_ * 1024);
        ++ui_;
        const int row0 = u.pm * BM + wr * 64 + fr;
        const int colt = wc * 32 + 8 * fq;
#pragma unroll
        for (int ai = 0; ai < 2; ++ai)
#pragma unroll
            for (int m = 0; m < 4; ++m) { const float rs = RS[ai * HALF + wr * 64 + m * 16 + fr];
#pragma unroll
                for (int bj = 0; bj < 2; ++bj)
#pragma unroll
                    for (int n = 0; n < 2; ++n) acc[ai][bj][m][n] = acc[ai][bj][m][n] * rs; }
        if (fr >= 14) {
#pragma unroll
            for (int ai = 0; ai < 2; ++ai) { const int blk = 2 * ai + wr;
#pragma unroll
                for (int bj = 0; bj < 2; ++bj)
#pragma unroll
                    for (int n = 0; n < 2; ++n) { const int col = bj * HALF + colt + 4 * n; const f32x4 v = acc[ai][bj][3][n];
                        *(PG8_LAS f32x4*)(ex + (blk * 2 + (fr - 14)) * 256 + col) = v;
                        if (blk == 3) { *(f32x4*)(UT + ((size_t)u.pm * 2 + (fr - 14)) * 5632 + u.pn * 256 + col) = v;
                            if ((u.pm & 7) == 7) *(f32x4*)(ffn_out + ((size_t)(u.pm >> 3) * 2 + (fr - 14)) * 5632 + bj * 2816 + u.pn * 128 + colt + 4 * n) = v; } } }
        }
        if (fr < 2 && wr == 0) {
#pragma unroll
            for (int bj = 0; bj < 2; ++bj)
#pragma unroll
                for (int n = 0; n < 2; ++n) *(f32x4*)(UH + ((size_t)u.pm * 2 + fr) * 5632 + u.pn * 256 + bj * HALF + colt + 4 * n) = acc[0][bj][0][n];
        }
        asm volatile("s_waitcnt lgkmcnt(0)" ::: "memory"); __builtin_amdgcn_s_barrier(); asm volatile("" ::: "memory");
#pragma unroll
        for (int ai = 0; ai < 2; ++ai) { const int blk = 2 * ai + wr;
#pragma unroll
            for (int n = 0; n < 2; ++n) {
#pragma unroll
                for (int bj = 0; bj < 2; ++bj) { const int col = bj * HALF + colt + 4 * n; asm volatile("" ::: "memory");
                    const f32x4 w0 = *(const PG8_LAS f32x4*)(W + col), w1 = *(const PG8_LAS f32x4*)(W + 256 + col), w2 = *(const PG8_LAS f32x4*)(W + 512 + col), bb = *(const PG8_LAS f32x4*)(W + 768 + col);
                    f32x4 vprev = (f32x4){0.f, 0.f, 0.f, 0.f};
                    if (blk > 0 && fr >= 14) vprev = *(const PG8_LAS f32x4*)(ex + ((blk - 1) * 2 + (fr - 14)) * 256 + col);
#pragma unroll
                    for (int m = 3; m >= 0; --m) { const f32x4 cur = acc[ai][bj][m][n]; const f32x4 prv = (m > 0) ? acc[ai][bj][m - 1][n] : vprev; f32x4 o;
#pragma unroll
                        for (int e = 0; e < 4; ++e) { const float t1 = (fr == 15) ? prv[e] : cur[e], t2 = (fr >= 14) ? prv[e] : cur[e];
                            o[e] = bb[e] + w0[e] * dpp_ror2(t2) + w1[e] * dpp_ror1(t1) + w2[e] * cur[e]; }
                        acc[ai][bj][m][n] = o; } }
#pragma unroll
                for (int m = 0; m < 4; ++m) { const f32x4 g = acc[ai][0][m][n], v = acc[ai][1][m][n]; f32x4 h;
#pragma unroll
                    for (int e = 0; e < 4; ++e) h[e] = silu_f(g[e]) * v[e];
                    acc[ai][0][m][n] = h; asm volatile("" : "+v"(acc[ai][0][m][n])); } }
#pragma unroll
            for (int m = 0; m < 4; ++m) { const f32x4 h0 = acc[ai][0][m][0], h1 = acc[ai][0][m][1];
                u32x4 w; w.x = cvt_pk_bf16(h0[0], h0[1]); w.y = cvt_pk_bf16(h0[2], h0[3]); w.z = cvt_pk_bf16(h1[0], h1[1]); w.w = cvt_pk_bf16(h1[2], h1[3]);
                *(u32x4*)(H + (size_t)(row0 + ai * HALF + m * 16) * 2816 + u.pn * 128 + colt) = w; } }
    }
};
template <class Epi, class Sched, bool ALIGN_EPI = false, bool SP2 = false>
__device__ __forceinline__ void gemm_phase(PG8_LAS unsigned char* lds, const Gemm g, const Sched& S, const Epi& E, const int tid) {
    const int wid = __builtin_amdgcn_readfirstlane(tid >> 6), lane = tid & 63, wr = wid >> 2, wc = wid & 3, fr = lane & 15, fq = lane >> 4;
    const int K = g.K, nt = K / BK;
    unsigned voffA[2], voffB[2];
#pragma unroll
    for (int i = 0; i < 2; ++i) { int R, C; stage_rc(tid * 16 + i * 8192, R, C); const int Rb = Epi::PERM ? ((R & ~31) + perm32(R & 31)) : R;
        voffA[i] = (unsigned)(R * K + C) * 2u; voffB[i] = (unsigned)(Rb * K + C) * 2u; }
    const size_t kstep = (size_t)(BK * 2);
    const size_t hstep = (size_t)HALF * K * 2;
    const size_t tstep = 2 * hstep;
    const unsigned ldsw = (unsigned)wid * 1024u;
    const int aoff = lds_byte(wr * 64 + fr, fq * 8), boff = lds_byte(wc * 32 + fr, fq * 8);
#define PG8_SA(b, h) (((b) * 2 + (h)) * HTB)
#define PG8_SB(b, h) ((4 + (b) * 2 + (h)) * HTB)
#define PG8_STAGE(bufoff, gbase, voff) do { _Pragma("unroll") for (int _i = 0; _i < 2; ++_i) \
        __builtin_amdgcn_global_load_lds((const unsigned*)((const char*)(gbase) + (voff)[_i]), (PG8_LAS unsigned*)(lds + (bufoff) + ldsw + _i * 8192), 16, 0, 0); } while (0)
#define PG8_LDA(dst, b, h) do { _Pragma("unroll") for (int m = 0; m < 4; ++m) _Pragma("unroll") for (int k = 0; k < 2; ++k) dst[m][k] = *(const PG8_LAS bf16x8*)(lds + PG8_SA(b, h) + aoff + m * 2048 + k * 1024); } while (0)
#define PG8_LDB(dst, b, h) do { _Pragma("unroll") for (int n = 0; n < 2; ++n) _Pragma("unroll") for (int k = 0; k < 2; ++k) dst[n][k] = *(const PG8_LAS bf16x8*)(lds + PG8_SB(b, h) + boff + n * 2048 + k * 1024); } while (0)
#define PG8_MMA(ai, bj, At, Bt) do { __builtin_amdgcn_s_setprio(1); _Pragma("unroll") for (int m = 0; m < 4; ++m) _Pragma("unroll") for (int n = 0; n < 2; ++n) _Pragma("unroll") for (int k = 0; k < 2; ++k) \
        acc[ai][bj][m][n] = __builtin_amdgcn_mfma_f32_16x16x32_bf16(Bt[n][k], At[m][k], acc[ai][bj][m][n], 0, 0, 0); __builtin_amdgcn_s_setprio(0); } while (0)
#define PG8_WAIT_V(n) asm volatile("s_waitcnt vmcnt(" #n ")" ::: "memory")
#define PG8_WAIT_L(n) asm volatile("s_waitcnt lgkmcnt(" #n ")" ::: "memory")
#define PG8_BAR __builtin_amdgcn_s_barrier()
#define PG8_SCHED __builtin_amdgcn_sched_barrier(0)
    Unit cur, nxt; int ui = 0;
    if (!S.next(0, cur)) return;
    f32x4 acc[2][2][4][2];
#pragma unroll
    for (int a = 0; a < 2; ++a)
#pragma unroll
        for (int b = 0; b < 2; ++b)
#pragma unroll
            for (int m = 0; m < 4; ++m)
#pragma unroll
                for (int n = 0; n < 2; ++n) acc[a][b][m][n] = (f32x4){0.f, 0.f, 0.f, 0.f};
    bf16x8 At[4][2], B0[2][2], B1[2][2];
    const char* cA = (const char*)g.A + (size_t)cur.pm * tstep; const char* cB = (const char*)g.Bt + (size_t)cur.pn * tstep;
    S.a_ready(cur);
    if constexpr (SP2) {
        PG8_STAGE(PG8_SB(0, 0), cB, voffB); PG8_STAGE(PG8_SB(0, 1), cB + hstep, voffB); PG8_STAGE(PG8_SA(0, 0), cA, voffA); PG8_STAGE(PG8_SA(0, 1), cA + hstep, voffA);
        if (wr == 1) PG8_BAR;
        PG8_WAIT_V(2); PG8_BAR;
        PG8_STAGE(PG8_SB(1, 0), cB + kstep, voffB); PG8_STAGE(PG8_SA(1, 0), cA + kstep, voffA); PG8_STAGE(PG8_SB(1, 1), cB + hstep + kstep, voffB);
        PG8_WAIT_V(6); PG8_BAR;
    } else {
        PG8_STAGE(PG8_SB(0, 0), cB, voffB); PG8_STAGE(PG8_SA(0, 0), cA, voffA); PG8_STAGE(PG8_SB(0, 1), cB + hstep, voffB); PG8_STAGE(PG8_SA(0, 1), cA + hstep, voffA);
        if (wr == 1) PG8_BAR;
        PG8_WAIT_V(4); PG8_BAR;
        PG8_STAGE(PG8_SB(1, 0), cB + kstep, voffB); PG8_STAGE(PG8_SA(1, 0), cA + kstep, voffA); PG8_STAGE(PG8_SB(1, 1), cB + hstep + kstep, voffB);
        PG8_WAIT_V(6); PG8_BAR;
    }
    for (;;) {
        const bool has_next = S.next(ui + 1, nxt);
        const char* nA = has_next ? (const char*)g.A + (size_t)nxt.pm * tstep : cA; const char* nB = has_next ? (const char*)g.Bt + (size_t)nxt.pn * tstep : cB;
        for (int t = 0; t < nt; t += 2) {
            const bool last = (t == nt - 2);
            const char* a1 = cA + (size_t)(t + 1) * kstep;
            const char* a2 = last ? nA : cA + (size_t)(t + 2) * kstep; const char* b2 = last ? nB : cB + (size_t)(t + 2) * kstep;
            const char* a3 = a2 + kstep; const char* b3 = b2 + kstep;
            if (last && has_next) S.a_ready(nxt);
            if constexpr (SP2) {
            PG8_LDB(B0, 0, 0); PG8_LDB(B1, 0, 1); PG8_SCHED; PG8_LDA(At, 0, 0); PG8_STAGE(PG8_SA(1, 1), a1 + hstep, voffA);
            PG8_WAIT_V(8); PG8_WAIT_L(0); PG8_BAR; PG8_MMA(0, 0, At, B0); PG8_MMA(0, 1, At, B1); PG8_BAR; PG8_SCHED;
            PG8_LDA(At, 0, 1); PG8_STAGE(PG8_SB(0, 0), b2, voffB); PG8_STAGE(PG8_SB(0, 1), b2 + hstep, voffB); PG8_STAGE(PG8_SA(0, 0), a2, voffA);
            PG8_WAIT_V(8); PG8_WAIT_L(0); PG8_BAR; PG8_MMA(1, 0, At, B0); PG8_MMA(1, 1, At, B1); PG8_BAR; PG8_SCHED;
            PG8_LDB(B0, 1, 0); PG8_LDB(B1, 1, 1); PG8_SCHED; PG8_LDA(At, 1, 0); PG8_STAGE(PG8_SA(0, 1), a2 + hstep, voffA);
            PG8_WAIT_V(8); PG8_WAIT_L(0); PG8_BAR; PG8_MMA(0, 0, At, B0); PG8_MMA(0, 1, At, B1); PG8_BAR; PG8_SCHED;
            PG8_LDA(At, 1, 1); PG8_STAGE(PG8_SB(1, 0), b3, voffB); PG8_STAGE(PG8_SB(1, 1), b3 + hstep, voffB); PG8_STAGE(PG8_SA(1, 0), a3, voffA);
            PG8_WAIT_V(8); PG8_WAIT_L(0); PG8_BAR; PG8_MMA(1, 0, At, B0); PG8_MMA(1, 1, At, B1); PG8_BAR; PG8_SCHED;
            } else {
            PG8_LDB(B0, 0, 0); PG8_SCHED; PG8_LDA(At, 0, 0); PG8_STAGE(PG8_SA(1, 1), a1 + hstep, voffA);
            PG8_WAIT_L(8); PG8_BAR; PG8_WAIT_L(0); PG8_MMA(0, 0, At, B0); PG8_BAR; PG8_SCHED;
            PG8_LDB(B1, 0, 1); PG8_STAGE(PG8_SB(0, 0), b2, voffB);
            PG8_BAR; PG8_WAIT_L(0); PG8_MMA(0, 1, At, B1); PG8_BAR;
            PG8_LDA(At, 0, 1); PG8_STAGE(PG8_SA(0, 0), a2, voffA);
            PG8_BAR; PG8_WAIT_L(0); PG8_MMA(1, 0, At, B0); PG8_BAR; PG8_SCHED;
            PG8_STAGE(PG8_SB(0, 1), b2 + hstep, voffB);
            PG8_WAIT_V(6); PG8_BAR; PG8_MMA(1, 1, At, B1); PG8_BAR;
            PG8_LDB(B0, 1, 0); PG8_SCHED; PG8_LDA(At, 1, 0); PG8_STAGE(PG8_SA(0, 1), a2 + hstep, voffA);
            PG8_WAIT_L(8); PG8_BAR; PG8_WAIT_L(0); PG8_MMA(0, 0, At, B0); PG8_BAR; PG8_SCHED;
            PG8_LDB(B1, 1, 1); PG8_STAGE(PG8_SB(1, 0), b3, voffB);
            PG8_BAR; PG8_WAIT_L(0); PG8_MMA(0, 1, At, B1); PG8_BAR;
            PG8_LDA(At, 1, 1); PG8_STAGE(PG8_SA(1, 0), a3, voffA);
            PG8_BAR; PG8_WAIT_L(0); PG8_MMA(1, 0, At, B0); PG8_BAR; PG8_SCHED;
            PG8_STAGE(PG8_SB(1, 1), b3 + hstep, voffB);
            PG8_WAIT_V(6); PG8_BAR; PG8_MMA(1, 1, At, B1); PG8_BAR;
            }
        }
        if constexpr (ALIGN_EPI) { if (wr == 0) PG8_BAR; }
        if constexpr (!Epi::AFTER_DRAIN) { E(acc, cur, wr, wc, fr, fq); S.done(cur); }
        if (!has_next) break;
#pragma unroll
        for (int a = 0; a < 2; ++a)
#pragma unroll
            for (int b = 0; b < 2; ++b)
#pragma unroll
                for (int m = 0; m < 4; ++m)
#pragma unroll
                    for (int n = 0; n < 2; ++n) acc[a][b][m][n] = (f32x4){0.f, 0.f, 0.f, 0.f};
        cur = nxt; cA = nA; cB = nB; ++ui;
        if constexpr (ALIGN_EPI) { if (wr == 1) PG8_BAR; }
    }
    PG8_WAIT_V(0);
    if constexpr (!ALIGN_EPI) { if (wr == 0) PG8_BAR; }
    PG8_BAR;
    if constexpr (Epi::AFTER_DRAIN) { E.fused(acc, cur, wr, wc, fr, fq, lds, wid, lane); S.done(cur); }
#undef PG8_SA
#undef PG8_SB
#undef PG8_STAGE
#undef PG8_LDA
#undef PG8_LDB
#undef PG8_MMA
#undef PG8_WAIT_V
#undef PG8_WAIT_L
#undef PG8_BAR
#undef PG8_SCHED
}
}

namespace mk {
constexpr int NWAVES = 8, NT = 512;
constexpr int DM = 1024, MP = 16384, NS = 128, SEQ = 2048, NB = 8;
constexpr int NPROJ = 4096, INC = 4120, UPN = 5632, DFF = 2816, DMIX = 2048, CONVD = 2048;
constexpr int NH = 24;
constexpr int PZ = 0, PX = 1536, PV = 3584;
constexpr float EPS = 1e-6f;
constexpr size_t O_YP = 0, O_YS = 16777216, O_SSMP = 16908288, O_SSMS = 17694720, O_CONVP = 30277632, O_CONVS = 30326784,
                 O_POOLP = 31113216, O_POOLS = 31174656, O_FFNP = 32157696, O_FFNS = 32247808, O_END = 33689600;
constexpr size_t KiB = 1024, MiB = 1048576;
constexpr size_t WS_CTL = 0, CTL_BYTES = 64 * KiB;
constexpr size_t WS_WIN = 64 * KiB;
constexpr size_t WS_WOUT = WS_WIN + 8 * MiB;
constexpr size_t WS_WUP = WS_WOUT + 4 * MiB;
constexpr size_t WS_WDN = WS_WUP + 11 * MiB;
constexpr size_t WS_WDT = WS_WDN + 5632 * KiB;
constexpr size_t WS_PWT = WS_WDT + 64 * KiB;
constexpr size_t WS_A = WS_PWT + 128 * KiB;
constexpr size_t WS_B = WS_A + 32 * MiB;
constexpr size_t WS_Y = WS_B + 128 * MiB;
constexpr size_t WS_DT = WS_Y + 64 * MiB;
constexpr size_t WS_CDEC = WS_DT + 1536 * KiB;
constexpr size_t WS_X1S = WS_CDEC + 16 * KiB;
constexpr size_t WS_XN2S = WS_X1S + 512 * KiB;
constexpr size_t WS_XN1S = WS_XN2S + 256 * KiB;
constexpr size_t WS_FCW = WS_XN1S + 256 * KiB;
constexpr size_t WS_END = WS_FCW + 128 * KiB;
static_assert(WS_END <= 256 * MiB, "workspace map");
constexpr size_t WB_H = 0, WB_UT = 88 * MiB, WB_UH = 91 * MiB, WB_SSP = 94 * MiB, WB_SSP2 = 95 * MiB, WB_HS = 96 * MiB, WB_X2S = 97 * MiB;
constexpr size_t OS_PROJS = O_FFNS, OS_DTS = O_FFNS + 128 * 4096, OS_YS = OS_DTS + 128 * 32;
static_assert(OS_YS + 131072 <= O_END, "sample scratch");
constexpr int LDS_BYTES = 163840, RING_OFF = 0, EX_OFF = 131072, MISC_OFF = LDS_BYTES - 512;
constexpr int CW_BAR = 4096;

#define LAS __attribute__((address_space(3)))
typedef unsigned short bf16;
typedef unsigned v4u __attribute__((ext_vector_type(4)));
typedef unsigned v2u __attribute__((ext_vector_type(2)));
typedef float f32x4 __attribute__((ext_vector_type(4)));
typedef short bf16x8 __attribute__((ext_vector_type(8)));
typedef short s16x4 __attribute__((ext_vector_type(4)));
#define LDS_WAIT() asm volatile("s_waitcnt lgkmcnt(0)" ::: "memory")
#define VM_WAIT() asm volatile("s_waitcnt vmcnt(0)" ::: "memory")
using pg8::cvt_pk_bf16; using pg8::silu_f;
__device__ __forceinline__ float bf2f(short h) { return __uint_as_float(((unsigned)(unsigned short)h) << 16); }
__device__ __forceinline__ unsigned short f2bf(float f) { return (unsigned short)(cvt_pk_bf16(f, 0.f) & 0xffffu); }
__device__ __forceinline__ float softplus_f(float x) { return x > 20.f ? x : log1pf(__expf(x)); }
__device__ __forceinline__ float wave_sum(float v) {
#pragma unroll
    for (int o = 1; o < 64; o <<= 1) v += __shfl_xor(v, o);
    return v;
}
__device__ __forceinline__ bf16x8 cat8(s16x4 lo, s16x4 hi) { bf16x8 r; r[0] = lo[0]; r[1] = lo[1]; r[2] = lo[2]; r[3] = lo[3]; r[4] = hi[0]; r[5] = hi[1]; r[6] = hi[2]; r[7] = hi[3]; return r; }
__device__ __forceinline__ s16x4 tr_read(const LAS bf16* p) { return __builtin_amdgcn_ds_read_tr16_b64_v4i16((LAS s16x4*)p); }
__device__ __forceinline__ int lane_now() { int t; asm volatile("v_mbcnt_lo_u32_b32 %0, -1, 0\n\tv_mbcnt_hi_u32_b32 %0, -1, %0" : "=v"(t)); return t; }
#define MFMA16(a, b, c) __builtin_amdgcn_mfma_f32_16x16x32_bf16((a), (b), (c), 0, 0, 0)
#define ARG(name, k) const float* const name = arg_in(k)
__device__ __forceinline__ const float* arg_in(int k) {
    typedef __attribute__((address_space(4))) const char* kptr_t; typedef __attribute__((address_space(1))) const float* gptr_t;
    kptr_t p = (kptr_t)__builtin_amdgcn_kernarg_segment_ptr(); asm volatile("" : "+s"(p));
    const unsigned long long raw = *(__attribute__((address_space(4))) const unsigned long long*)(p + 8 * k);
    return (const float*)(gptr_t)raw; }

#define XB_TMO      128
#define XB_XCNT(j)  (256  + 64 * (j))
#define XB_XSUB(j)  (1280 + 64 * (j))
#define XB_XGEN(j)  (2304 + 64 * (j))
#define XB_TOP      3328
#define XB_TOPGEN   3392
#define XCD_BAR_WORDS 3456
#define XB_SPIN_CAP (1u << 18)

__device__ __forceinline__ unsigned xb_ld(unsigned* p)              { return __hip_atomic_load(p, __ATOMIC_RELAXED, __HIP_MEMORY_SCOPE_AGENT); }
__device__ __forceinline__ unsigned xb_add(unsigned* p, unsigned v) { return __hip_atomic_fetch_add(p, v, __ATOMIC_RELAXED, __HIP_MEMORY_SCOPE_AGENT); }
__device__ __forceinline__ unsigned xb_xcc_id() { return (unsigned)__builtin_amdgcn_s_getreg((3 << 11) | 20) & 0xFu; }
#define XB_SPIN(cond, bar) do { unsigned _sp = 0; while (cond) { __builtin_amdgcn_s_sleep(1); \
    if ((++_sp & 255u) == 0u) { if (xb_ld(&(bar)[XB_TMO])) break; if (_sp > XB_SPIN_CAP) { atomicAdd(&(bar)[XB_TMO], 1u); break; } } } } while (0)

struct XcdBarrier {
    unsigned* bar; unsigned x;
    volatile LAS unsigned* st;
};

__device__ __forceinline__ XcdBarrier xcd_barrier_post(unsigned* bar, volatile LAS unsigned* st, const bool t0) {
    XcdBarrier b; b.bar = bar; b.x = xb_xcc_id(); b.st = st;
    if (t0) (void)xb_add(&bar[XB_XCNT(b.x)], 1u);
    return b;
}
__device__ __forceinline__ void xcd_barrier_complete(unsigned* bar, unsigned x, unsigned& nloc, unsigned& nx) {
    const unsigned G = gridDim.x * gridDim.y * gridDim.z;
    unsigned sum, cnt, mine, sp = 0u;
    for (;;) {
        sum = 0u; cnt = 0u; mine = 0u;
#pragma unroll
        for (unsigned j = 0; j < 16; ++j) { const unsigned c = xb_ld(&bar[XB_XCNT(j)]); sum += c; cnt += (c > 0u) ? 1u : 0u; mine = (j == x) ? c : mine; }
        if (sum == G) break;
        __builtin_amdgcn_s_sleep(1);
        if ((++sp & 255u) == 0u) { if (xb_ld(&bar[XB_TMO])) break; if (sp > XB_SPIN_CAP) { atomicAdd(&bar[XB_TMO], 1u); break; } }
    }
    nloc = mine > 0u ? mine : 1u; nx = cnt > 0u ? cnt : 1u;
}

__device__ __forceinline__ void xcd_barrier(const XcdBarrier& b, const bool t0) {
    asm volatile("s_waitcnt vmcnt(0)" ::: "memory");
    __syncthreads();
    if (t0) {
        unsigned* bar = b.bar;
        __builtin_amdgcn_s_waitcnt(0);
        unsigned nloc = b.st[0], nx = b.st[1];
        if (nloc == 0u) { xcd_barrier_complete(bar, b.x, nloc, nx); b.st[0] = nloc; b.st[1] = nx; }
        const unsigned old = xb_add(&bar[XB_XSUB(b.x)], 1u);
        const unsigned gen = old / nloc;
        if (old + 1u == (gen + 1u) * nloc) {
            __builtin_amdgcn_fence(__ATOMIC_RELEASE, "agent");
            asm volatile("s_waitcnt vmcnt(0)" ::: "memory");
            const unsigned og = xb_add(&bar[XB_TOP], 1u);
            const unsigned tg = og / nx;
            if (og + 1u == (tg + 1u) * nx) xb_add(&bar[XB_TOPGEN], 1u);
            else XB_SPIN(xb_ld(&bar[XB_TOPGEN]) == tg, bar);
            __builtin_amdgcn_fence(__ATOMIC_ACQUIRE, "agent");
            xb_add(&bar[XB_XGEN(b.x)], 1u);
            asm volatile("s_waitcnt vmcnt(0)" ::: "memory");
        } else {
            XB_SPIN(xb_ld(&bar[XB_XGEN(b.x)]) == gen, bar);
            __builtin_amdgcn_fence(__ATOMIC_ACQUIRE, "agent");
            asm volatile("s_waitcnt vmcnt(0)" ::: "memory");
        }
    }
    __syncthreads();
}

struct Ctx { LAS unsigned char* lds; int tid, lane, wave, vcu, G; };

__device__ __forceinline__ void transpose_item(const float* W, int ldw, int k0, int ns0, int nvalid, bf16* WT, int K, int drow0, const float* fold, LAS float* scr, int lane) {
#pragma unroll 8
    for (int i = 0; i < 32; ++i) { const int kk = 2 * i + (lane >> 5), nn = lane & 31;
        float v = (nn < nvalid) ? W[(size_t)(k0 + kk) * ldw + ns0 + nn] : 0.f;
        if (fold) v *= fold[k0 + kk];
        scr[kk * 33 + nn] = v; }
    LDS_WAIT(); asm volatile("" ::: "memory");
    const int c = lane & 7;
#pragma unroll
    for (int j = 0; j < 4; ++j) { const int n = (lane >> 3) + 8 * j; const LAS float* s = scr + (8 * c) * 33 + n;
        v4u o; o.x = cvt_pk_bf16(s[0 * 33], s[1 * 33]); o.y = cvt_pk_bf16(s[2 * 33], s[3 * 33]); o.z = cvt_pk_bf16(s[4 * 33], s[5 * 33]); o.w = cvt_pk_bf16(s[6 * 33], s[7 * 33]);
        *(v4u*)(WT + (size_t)(drow0 + n) * K + k0 + 8 * c) = o; }
    LDS_WAIT(); asm volatile("" ::: "memory");
}
__device__ __forceinline__ void rms_row_to_bf16(const float* xrow, const float* w, bf16* orow, int lane) {
    const f32x4* xr = (const f32x4*)xrow + lane;
    f32x4 v[4]; float s = 0.f;
#pragma unroll
    for (int j = 0; j < 4; ++j) { v[j] = xr[64 * j]; s += (v[j][0] * v[j][0] + v[j][1] * v[j][1]) + (v[j][2] * v[j][2] + v[j][3] * v[j][3]); }
    const float rs = 1.0f / sqrtf(wave_sum(s) * (1.0f / 1024.0f) + EPS);
    v2u* o8 = (v2u*)orow + lane;
#pragma unroll
    for (int j = 0; j < 4; ++j) { f32x4 ww = (f32x4){1.f, 1.f, 1.f, 1.f}; if (w) ww = ((const f32x4*)w)[lane + 64 * j];
        v2u o; o.x = cvt_pk_bf16(v[j][0] * rs * ww[0], v[j][1] * rs * ww[1]); o.y = cvt_pk_bf16(v[j][2] * rs * ww[2], v[j][3] * rs * ww[3]); o8[64 * j] = o; }
}

template <int R16, int K> __device__ __forceinline__ void skinny_acc(const bf16* A, const bf16* Wt, int row0, int n0, int wave, int lane, f32x4 (&acc)[R16]) {
    constexpr int KW = K / 8, NS_ = KW / 32;
    static_assert(KW % 32 == 0, "K split");
    const bf16* ap = A + (size_t)(row0 + (lane & 15)) * K + wave * KW + 8 * (lane >> 4);
    const bf16* bp = Wt + (size_t)(n0 + (lane & 15)) * K + wave * KW + 8 * (lane >> 4);
#pragma unroll
    for (int mi = 0; mi < R16; ++mi) acc[mi] = (f32x4){0.f, 0.f, 0.f, 0.f};
#pragma unroll
    for (int ks = 0; ks < NS_; ++ks) { const bf16x8 b = *(const bf16x8*)(bp + 32 * ks);
#pragma unroll
        for (int mi = 0; mi < R16; ++mi) { const bf16x8 a = *(const bf16x8*)(ap + (size_t)mi * 16 * K + 32 * ks); acc[mi] = MFMA16(a, b, acc[mi]); } }
}
template <int R16> __device__ __forceinline__ f32x4 skinny_reduce(LAS float* red, const f32x4 (&acc)[R16], int wave, int lane, int tid) {
#pragma unroll
    for (int mi = 0; mi < R16; ++mi) *(LAS f32x4*)(red + ((wave * R16 + mi) * 64 + lane) * 4) = acc[mi];
    __syncthreads();
    f32x4 s = (f32x4){0.f, 0.f, 0.f, 0.f};
    if ((tid >> 6) < R16) {
#pragma unroll
        for (int w = 0; w < 8; ++w) s += *(const LAS f32x4*)(red + ((w * R16 + (tid >> 6)) * 64 + (tid & 63)) * 4);
    }
    __syncthreads();
    return s;
}

constexpr int XS = 392, BS = 72;
constexpr int S_XS = 0, S_BS = 128 * XS * 2, S_CS = S_BS + 128 * BS * 2, S_AC = S_CS + 128 * BS * 2, S_DT = S_AC + 6 * 128 * 4, S_WV = S_DT + 6 * 128 * 4, S_END = S_WV + 6 * 128 * 4;
static_assert(S_END <= MISC_OFF, "S-phase LDS map");
template <bool WITH_C> __device__ __forceinline__ void conv_stage(const Ctx& F, const bf16* PROJ, int b, int c, int g, float* conv_out) {
    ARG(conv_w, 8);
    ARG(conv_b, 9);
    const int cg = F.tid & 63, rs = F.tid >> 6;
    int ch; LAS bf16* dst; int dstride;
    if (cg < 48) { ch = 384 * g + 8 * cg; dst = (LAS bf16*)(F.lds + S_XS) + 8 * cg; dstride = XS; }
    else if (cg < 56) { ch = 1536 + 64 * g + 8 * (cg - 48); dst = (LAS bf16*)(F.lds + S_BS) + 8 * (cg - 48); dstride = BS; }
    else { ch = 1792 + 64 * g + 8 * (cg - 56); dst = (LAS bf16*)(F.lds + S_CS) + 8 * (cg - 56); dstride = BS; }
    if (!WITH_C && cg >= 56) return;
    float w[4][8], bias[8];
#pragma unroll
    for (int k = 0; k < 4; ++k) { const f32x4 a = *(const f32x4*)(conv_w + k * CONVD + ch), d = *(const f32x4*)(conv_w + k * CONVD + ch + 4);
        w[k][0] = a[0]; w[k][1] = a[1]; w[k][2] = a[2]; w[k][3] = a[3]; w[k][4] = d[0]; w[k][5] = d[1]; w[k][6] = d[2]; w[k][7] = d[3]; }
    { const f32x4 a = *(const f32x4*)(conv_b + ch), d = *(const f32x4*)(conv_b + ch + 4);
        bias[0] = a[0]; bias[1] = a[1]; bias[2] = a[2]; bias[3] = a[3]; bias[4] = d[0]; bias[5] = d[1]; bias[6] = d[2]; bias[7] = d[3]; }
    const bf16* src = PROJ + ((size_t)b * SEQ + c * 128 + 16 * rs) * NPROJ + PX + ch;
    float r0[8], r1[8], r2[8];
    const bool zero_hist = (c == 0 && rs == 0);
    { bf16x8 h0 = {0,0,0,0,0,0,0,0}, h1 = h0, h2 = h0;
      if (!zero_hist) { h0 = *(const bf16x8*)(src - 3 * NPROJ); h1 = *(const bf16x8*)(src - 2 * NPROJ); h2 = *(const bf16x8*)(src - 1 * NPROJ); }
#pragma unroll
      for (int j = 0; j < 8; ++j) { r0[j] = bf2f(h0[j]); r1[j] = bf2f(h1[j]); r2[j] = bf2f(h2[j]); } }
#pragma unroll 4
    for (int i = 0; i < 16; ++i) { const int l = 16 * rs + i;
        const bf16x8 raw = *(const bf16x8*)(src + (size_t)i * NPROJ);
        float cur[8], o[8];
#pragma unroll
        for (int j = 0; j < 8; ++j) { cur[j] = bf2f(raw[j]); o[j] = silu_f(bias[j] + w[0][j] * r0[j] + w[1][j] * r1[j] + w[2][j] * r2[j] + w[3][j] * cur[j]); }
        v4u pk; pk.x = cvt_pk_bf16(o[0], o[1]); pk.y = cvt_pk_bf16(o[2], o[3]); pk.z = cvt_pk_bf16(o[4], o[5]); pk.w = cvt_pk_bf16(o[6], o[7]);
        *(LAS v4u*)(dst + l * dstride) = pk;
        if (conv_out && l >= 125) { float* op = conv_out + (size_t)(l - 125) * CONVD + ch;
            *(f32x4*)op = (f32x4){cur[0], cur[1], cur[2], cur[3]}; *(f32x4*)(op + 4) = (f32x4){cur[4], cur[5], cur[6], cur[7]}; }
#pragma unroll
        for (int j = 0; j < 8; ++j) { r0[j] = r1[j]; r1[j] = r2[j]; r2[j] = cur[j]; } }
}
__device__ __forceinline__ void dt_stage(const Ctx& F, const float* DT, int b, int c, int g, float* cdec_out) {
    ARG(a_log, 11);
    if (F.wave < 6) { const int hh = 6 * g + F.wave; const float a = -__expf(a_log[hh]);
        const size_t row = (size_t)b * SEQ + c * 128 + 2 * F.lane;
        const float d0 = DT[row * 24 + hh], d1 = DT[(row + 1) * 24 + hh];
        const float v0 = d0 * a, v1 = d1 * a; float s = v0 + v1;
#pragma unroll
        for (int o = 1; o < 64; o <<= 1) { const float t = __shfl_up(s, o); if (F.lane >= o) s += t; }
        const float tot = __shfl(s, 63);
        LAS float* ac = (LAS float*)(F.lds + S_AC) + F.wave * 128 + 2 * F.lane;
        LAS float* dl = (LAS float*)(F.lds + S_DT) + F.wave * 128 + 2 * F.lane;
        LAS float* wv = (LAS float*)(F.lds + S_WV) + F.wave * 128 + 2 * F.lane;
        const float a0 = s - v1, a1 = s;
        ac[0] = a0; ac[1] = a1; dl[0] = d0; dl[1] = d1; wv[0] = __expf(tot - a0) * d0; wv[1] = __expf(tot - a1) * d1;
        if (cdec_out && F.lane == 0) cdec_out[hh] = __expf(tot); }
}

__device__ __forceinline__ void s1_unit(const Ctx& F, const bf16* PROJ, const float* DT, float* CS, float* CDEC, float* conv_prompt, int unit) {
    const int g = unit & 3, c = (unit >> 2) & 15, b = unit >> 6;
    conv_stage<true>(F, PROJ, b, c, g, (c == 15) ? conv_prompt + (size_t)b * 3 * CONVD : nullptr);
    dt_stage(F, DT, b, c, g, CDEC + (b * 16 + c) * 24);
    __syncthreads();
    const int i = F.lane & 15, g4 = F.lane >> 4;
    const LAS bf16* xs = (const LAS bf16*)(F.lds + S_XS); const LAS bf16* Bs = (const LAS bf16*)(F.lds + S_BS); const LAS float* wv = (const LAS float*)(F.lds + S_WV);
    bf16x8 Bf[4][4];
#pragma unroll
    for (int nt = 0; nt < 4; ++nt)
#pragma unroll
        for (int ks = 0; ks < 4; ++ks) { const LAS bf16* p = Bs + (32 * ks + 4 * g4 + (i >> 2)) * BS + 16 * nt + 4 * (i & 3); Bf[nt][ks] = cat8(tr_read(p), tr_read(p + 16 * BS)); }
#pragma unroll 1
    for (int pr = 0; pr < 3; ++pr) { const int pair = F.wave * 3 + pr, h = pair >> 2, pt = pair & 3;
        bf16x8 Af[4];
#pragma unroll
        for (int ks = 0; ks < 4; ++ks) { const LAS bf16* p = xs + (32 * ks + 4 * g4 + (i >> 2)) * XS + 64 * h + 16 * pt + 4 * (i & 3);
            const s16x4 lo = tr_read(p), hi = tr_read(p + 16 * XS);
            const f32x4 w0 = *(const LAS f32x4*)(wv + h * 128 + 32 * ks + 4 * g4), w1 = *(const LAS f32x4*)(wv + h * 128 + 32 * ks + 16 + 4 * g4);
            v4u pk; pk.x = cvt_pk_bf16(bf2f(lo[0]) * w0[0], bf2f(lo[1]) * w0[1]); pk.y = cvt_pk_bf16(bf2f(lo[2]) * w0[2], bf2f(lo[3]) * w0[3]);
            pk.z = cvt_pk_bf16(bf2f(hi[0]) * w1[0], bf2f(hi[1]) * w1[1]); pk.w = cvt_pk_bf16(bf2f(hi[2]) * w1[2], bf2f(hi[3]) * w1[3]);
            Af[ks] = __builtin_bit_cast(bf16x8, pk); }
        f32x4 acc[4];
#pragma unroll
        for (int nt = 0; nt < 4; ++nt) { acc[nt] = (f32x4){0.f, 0.f, 0.f, 0.f};
#pragma unroll
            for (int ks = 0; ks < 4; ++ks) acc[nt] = MFMA16(Bf[nt][ks], Af[ks], acc[nt]); }
        float* o = CS + ((((size_t)b * 16 + c) * 24 + 6 * g + h) * 64 + 16 * pt + i) * 64 + 4 * g4;
#pragma unroll
        for (int nt = 0; nt < 4; ++nt) *(f32x4*)(o + 16 * nt) = acc[nt]; }
    __syncthreads();
}

constexpr int VS = 136;
constexpr int PL_V = 0, PL_M = 143 * VS * 2;
__device__ __forceinline__ void pool_unit(const Ctx& F, const bf16* PROJ, const bf16* PWt, bf16* Y, float* pool_prompt, int unit) {
    ARG(pool_scale, 15);
    const int g = unit & 3, tt = unit >> 2, b = tt >> 4, t0 = (tt & 15) * 128;
    LAS bf16* vs = (LAS bf16*)(F.lds + PL_V); LAS bf16* ms = (LAS bf16*)(F.lds + PL_M);
    for (int it = F.tid; it < 143 * 16; it += NT) { const int r = it >> 4, cgp = it & 15; const int t = t0 - 15 + r;
        v4u v = (v4u){0u, 0u, 0u, 0u};
        if (t >= 0) v = *(const v4u*)(PROJ + ((size_t)b * SEQ + t) * NPROJ + PV + 128 * g + 8 * cgp);
        *(LAS v4u*)(vs + r * VS + 8 * cgp) = v; }
    __syncthreads();
    const int w = 2 << g;
    for (int it = F.tid; it < 128 * 16; it += NT) { const int l = it >> 4, cgp = it & 15;
        float s[8] = {0.f, 0.f, 0.f, 0.f, 0.f, 0.f, 0.f, 0.f}; bf16x8 cur;
        for (int j = 0; j < w; ++j) { cur = *(const LAS bf16x8*)(vs + (l + 15 - (w - 1) + j) * VS + 8 * cgp);
#pragma unroll
            for (int e = 0; e < 8; ++e) s[e] += bf2f(cur[e]); }
        const int cnt = (t0 + l + 1 < w) ? (t0 + l + 1) : w; const float inv = 1.0f / (float)cnt;
        float o[8];
#pragma unroll
        for (int e = 0; e < 8; ++e) o[e] = s[e] * inv - bf2f(cur[e]);
        v4u pk; pk.x = cvt_pk_bf16(o[0], o[1]); pk.y = cvt_pk_bf16(o[2], o[3]); pk.z = cvt_pk_bf16(o[4], o[5]); pk.w = cvt_pk_bf16(o[6], o[7]);
        *(LAS v4u*)(ms + l * VS + 8 * cgp) = pk; }
    if ((tt & 15) == 15) {
        for (int it = F.tid; it < 15 * 128; it += NT) { const int r = it >> 7, cc = it & 127;
            pool_prompt[((size_t)b * 15 + r) * 512 + 128 * g + cc] = bf2f((short)vs[(128 + r) * VS + cc]); } }
    __syncthreads();
    const int i = F.lane & 15, g4 = F.lane >> 4;
    bf16x8 Af[4];
#pragma unroll
    for (int ks = 0; ks < 4; ++ks) Af[ks] = *(const LAS bf16x8*)(ms + (16 * F.wave + i) * VS + 32 * ks + 8 * g4);
    const size_t row = (size_t)b * SEQ + t0 + 16 * F.wave + i;
#pragma unroll
    for (int nt = 0; nt < 8; ++nt) { f32x4 acc = (f32x4){0.f, 0.f, 0.f, 0.f};
#pragma unroll
        for (int ks = 0; ks < 4; ++ks) { const bf16x8 bfr = *(const bf16x8*)(PWt + ((size_t)g * 128 + 16 * nt + i) * 128 + 32 * ks + 8 * g4); acc = MFMA16(bfr, Af[ks], acc); }
        const f32x4 sc = *(const f32x4*)(pool_scale + 128 * g + 16 * nt + 4 * g4);
        v2u pk; pk.x = cvt_pk_bf16(acc[0] * sc[0], acc[1] * sc[1]); pk.y = cvt_pk_bf16(acc[2] * sc[2], acc[3] * sc[3]);
        *(v2u*)(Y + row * DMIX + 1536 + 128 * g + 16 * nt + 4 * g4) = pk; }
    __syncthreads();
}

__device__ __forceinline__ void ssm_sample_unit(const Ctx& F, float* out, int unit) {
    ARG(state_ssm, 2);
    ARG(state_conv, 3);
    ARG(conv_w, 8);
    ARG(conv_b, 9);
    ARG(a_log, 11);
    ARG(d_skip, 12);
    ARG(ssd_norm_w, 13);
    const float* PROJS = out + OS_PROJS; const float* DTS = out + OS_DTS; bf16* YS = (bf16*)(out + OS_YS); float* ssm_out = out + O_SSMS; float* conv_out = out + O_CONVS;
    const int g = unit & 3, b = unit >> 2, tid = F.tid;
    LAS float* sx = (LAS float*)F.lds;
    LAS float* sy = sx + 512;
    LAS float* sred = sy + 384;
    const int p = tid >> 3, ng = tid & 7;
    f32x4 h0[6][2];
#pragma unroll
    for (int h = 0; h < 6; ++h) { const float* sp = state_ssm + ((((size_t)b * NH + 6 * g + h) * 64 + p) * 64 + 8 * ng); h0[h][0] = *(const f32x4*)sp; h0[h][1] = *(const f32x4*)(sp + 4); }
    { const int ch = (tid < 384) ? 384 * g + tid : (tid < 448 ? 1536 + 64 * g + (tid - 384) : 1792 + 64 * g + (tid - 448));
      const float* st = state_conv + (size_t)b * 3 * CONVD + ch; const float s0 = st[0], s1 = st[CONVD], s2 = st[2 * CONVD], nw = PROJS[(size_t)b * NPROJ + PX + ch];
      sx[tid] = silu_f(conv_b[ch] + conv_w[ch] * s0 + conv_w[CONVD + ch] * s1 + conv_w[2 * CONVD + ch] * s2 + conv_w[3 * CONVD + ch] * nw);
      float* co = conv_out + (size_t)b * 3 * CONVD + ch; co[0] = s1; co[CONVD] = s2; co[2 * CONVD] = nw; }
    __syncthreads();
    float bn[8], cn[8];
#pragma unroll
    for (int j = 0; j < 8; ++j) { bn[j] = sx[384 + 8 * ng + j]; cn[j] = sx[448 + 8 * ng + j]; }
    float ssq = 0.f;
#pragma unroll
    for (int h = 0; h < 6; ++h) { const int hh = 6 * g + h; const float dt = DTS[b * 24 + hh], dA = __expf(-dt * __expf(a_log[hh])); const float xp = sx[64 * h + p], dx = dt * xp;
        f32x4 n0, n1; float yp = 0.f;
#pragma unroll
        for (int j = 0; j < 4; ++j) { n0[j] = dA * h0[h][0][j] + dx * bn[j]; n1[j] = dA * h0[h][1][j] + dx * bn[4 + j]; yp += cn[j] * n0[j] + cn[4 + j] * n1[j]; }
        float* op = ssm_out + ((((size_t)b * NH + hh) * 64 + p) * 64 + 8 * ng); *(f32x4*)op = n0; *(f32x4*)(op + 4) = n1;
        yp += __shfl_xor(yp, 1); yp += __shfl_xor(yp, 2); yp += __shfl_xor(yp, 4);
        const float y = (yp + d_skip[hh] * xp) * silu_f(PROJS[(size_t)b * NPROJ + PZ + 64 * hh + p]);
        if (ng == 0) { sy[64 * h + p] = y; ssq += y * y; } }
    ssq = wave_sum(ssq);
    if (F.lane == 0) sred[F.wave] = ssq;
    __syncthreads();
    float tot = 0.f;
#pragma unroll
    for (int w = 0; w < 8; ++w) tot += sred[w];
    const float rs = 1.0f / sqrtf(tot * (1.0f / 384.0f) + EPS);
    if (tid < 384) YS[(size_t)b * DMIX + 384 * g + tid] = f2bf(sy[tid] * rs * ssd_norm_w[384 * g + tid]);
    __syncthreads();
}
__device__ __forceinline__ void pool_sample_unit(const Ctx& F, float* out, int b) {
    ARG(state_pool, 4);
    ARG(pool_w, 14);
    ARG(pool_scale, 15);
    const float* PROJS = out + OS_PROJS; bf16* YS = (bf16*)(out + OS_YS); float* pool_out = out + O_POOLS;
    LAS float* sm = (LAS float*)F.lds; const int tid = F.tid, g = F.wave >> 1, w = 2 << g;
    const float vn = PROJS[(size_t)b * NPROJ + PV + tid]; const float* sp = state_pool + (size_t)b * 15 * 512 + tid; float* po = pool_out + (size_t)b * 15 * 512 + tid;
    float s = vn;
#pragma unroll
    for (int r = 0; r < 15; ++r) { const float v = sp[r * 512]; if (r >= 15 - (w - 1)) s += v; if (r >= 1) po[(r - 1) * 512] = v; }
    po[14 * 512] = vn;
    sm[tid] = s * (1.0f / (float)w) - vn;
    __syncthreads();
    const int d = tid & 127; const float* pw = pool_w + (size_t)g * 16384 + d; float acc = 0.f;
#pragma unroll 8
    for (int c = 0; c < 128; ++c) acc += sm[128 * g + c] * pw[c * 128];
    YS[(size_t)b * DMIX + 1536 + tid] = f2bf(acc * pool_scale[tid]);
    __syncthreads();
}

__device__ __forceinline__ void s3_unit(const Ctx& F, const bf16* PROJ, const float* DT, const bf16* HIN, bf16* Y, int unit) {
    ARG(d_skip, 12);
    ARG(ssd_norm_w, 13);
    const int g = unit & 3, c = (unit >> 2) & 15, b = unit >> 6;
    conv_stage<true>(F, PROJ, b, c, g, nullptr);
    dt_stage(F, DT, b, c, g, nullptr);
    __syncthreads();
    const int i = F.lane & 15, g4 = F.lane >> 4, w = F.wave, lrow = 16 * w + i;
    const LAS bf16* xs = (const LAS bf16*)(F.lds + S_XS); const LAS bf16* Bs = (const LAS bf16*)(F.lds + S_BS); const LAS bf16* Cs = (const LAS bf16*)(F.lds + S_CS);
    const LAS float* acs = (const LAS float*)(F.lds + S_AC); const LAS float* dts = (const LAS float*)(F.lds + S_DT);
    bf16x8 Cf[2];
#pragma unroll
    for (int ks = 0; ks < 2; ++ks) Cf[ks] = *(const LAS bf16x8*)(Cs + lrow * BS + 32 * ks + 8 * g4);
    f32x4 X[8];
#pragma unroll
    for (int st = 0; st < 8; ++st) { X[st] = (f32x4){0.f, 0.f, 0.f, 0.f};
        if (st <= w) {
#pragma unroll
            for (int ks = 0; ks < 2; ++ks) { const bf16x8 a = *(const LAS bf16x8*)(Bs + (16 * st + i) * BS + 32 * ks + 8 * g4); X[st] = MFMA16(a, Cf[ks], X[st]); } } }
    const size_t grow = (size_t)b * SEQ + c * 128 + lrow;
    float mk[4], dg[4];
#pragma unroll
    for (int r = 0; r < 4; ++r) { mk[r] = (4 * g4 + r <= i) ? 1.f : 0.f; dg[r] = (4 * g4 + r == i) ? 1.f : 0.f; }
    float ssq = 0.f;
#pragma unroll 1
    for (int h = 0; h < 6; ++h) { const int hh = 6 * g + h; const float al = acs[h * 128 + lrow], Dh = d_skip[hh];
        f32x4 ya[4], yo[4];
#pragma unroll
        for (int pt = 0; pt < 4; ++pt) { ya[pt] = (f32x4){0.f, 0.f, 0.f, 0.f}; yo[pt] = (f32x4){0.f, 0.f, 0.f, 0.f}; }
#pragma unroll
        for (int u = 0; u < 4; ++u) { if (2 * u <= w) {
            float mv[8];
#pragma unroll
            for (int hf = 0; hf < 2; ++hf) { const int st = 2 * u + hf;
                if (st < w) { const f32x4 as4 = *(const LAS f32x4*)(acs + h * 128 + 16 * st + 4 * g4), dt4 = *(const LAS f32x4*)(dts + h * 128 + 16 * st + 4 * g4);
#pragma unroll
                    for (int r = 0; r < 4; ++r) mv[4 * hf + r] = X[st][r] * __expf(al - as4[r]) * dt4[r]; }
                else if (st == w) { const f32x4 as4 = *(const LAS f32x4*)(acs + h * 128 + 16 * st + 4 * g4), dt4 = *(const LAS f32x4*)(dts + h * 128 + 16 * st + 4 * g4);
#pragma unroll
                    for (int r = 0; r < 4; ++r) mv[4 * hf + r] = X[st][r] * __expf(fminf(al - as4[r], 0.f)) * dt4[r] * mk[r] + Dh * dg[r]; }
                else {
#pragma unroll
                    for (int r = 0; r < 4; ++r) mv[4 * hf + r] = 0.f; } }
            v4u pk; pk.x = cvt_pk_bf16(mv[0], mv[1]); pk.y = cvt_pk_bf16(mv[2], mv[3]); pk.z = cvt_pk_bf16(mv[4], mv[5]); pk.w = cvt_pk_bf16(mv[6], mv[7]);
            const bf16x8 mf = __builtin_bit_cast(bf16x8, pk);
#pragma unroll
            for (int pt = 0; pt < 4; ++pt) { const LAS bf16* p = xs + (32 * u + 4 * g4 + (i >> 2)) * XS + 64 * h + 16 * pt + 4 * (i & 3);
                const bf16x8 xf = cat8(tr_read(p), tr_read(p + 16 * XS)); ya[pt] = MFMA16(xf, mf, ya[pt]); } } }
        const bf16* hp = HIN + (((size_t)b * 16 + c) * 24 + hh) * 4096;
#pragma unroll
        for (int pt = 0; pt < 4; ++pt)
#pragma unroll
            for (int ks = 0; ks < 2; ++ks) { const bf16x8 hf = *(const bf16x8*)(hp + (16 * pt + i) * 64 + 32 * ks + 8 * g4); yo[pt] = MFMA16(hf, Cf[ks], yo[pt]); }
        const float el = __expf(al);
#pragma unroll
        for (int pt = 0; pt < 4; ++pt) { const s16x4 z4 = *(const s16x4*)(PROJ + grow * NPROJ + PZ + 64 * hh + 16 * pt + 4 * g4);
            float yy[4];
#pragma unroll
            for (int r = 0; r < 4; ++r) { const float y = (ya[pt][r] + el * yo[pt][r]) * silu_f(bf2f(z4[r])); yy[r] = y; ssq += y * y; }
            v2u pk; pk.x = cvt_pk_bf16(yy[0], yy[1]); pk.y = cvt_pk_bf16(yy[2], yy[3]);
            *(v2u*)(Y + grow * DMIX + 64 * hh + 16 * pt + 4 * g4) = pk; } }
    ssq += __shfl_xor(ssq, 16); ssq += __shfl_xor(ssq, 32);
    const float rs = 1.0f / sqrtf(ssq * (1.0f / 384.0f) + EPS);
    VM_WAIT();
#pragma unroll 2
    for (int hp2 = 0; hp2 < 24; ++hp2) { const int col = 384 * g + 16 * hp2 + 4 * g4; const f32x4 nw = *(const f32x4*)(ssd_norm_w + col);
        const v2u yb = *(const v2u*)(Y + grow * DMIX + col);
        v2u pk; pk.x = cvt_pk_bf16(__uint_as_float(yb.x << 16) * rs * nw[0], __uint_as_float(yb.x & 0xffff0000u) * rs * nw[1]); pk.y = cvt_pk_bf16(__uint_as_float(yb.y << 16) * rs * nw[2], __uint_as_float(yb.y & 0xffff0000u) * rs * nw[3]);
        *(v2u*)(Y + grow * DMIX + col) = pk; }
    __syncthreads();
}

struct Args { const float* in[23]; float* out; unsigned char* ws; int ph_lo, ph_hi; };
constexpr int NPHASE = 9;
#define MK_EN(k) (((MASK) >> (k)) & 1)
#ifndef MK_P2DUP
#define MK_P2DUP 0
#endif
#ifndef MK_P6DUP
#define MK_P6DUP 0
#endif
#ifndef MK_P7DUP
#define MK_P7DUP 0
#endif
#ifndef MK_P8DUP
#define MK_P8DUP 0
#endif
#ifndef MK_DUP
#define MK_DUP 0
#endif
#define MK_DUPK(k) (((MK_DUP) >> (k)) & 1)

template <int MASK> __global__ void __launch_bounds__(NT, 2) mk_fwd(Args args) {
    extern __shared__ __attribute__((aligned(16))) unsigned char lds_raw[];
    Ctx F;
    F.lds = (LAS unsigned char*)lds_raw;
    F.wave = __builtin_amdgcn_readfirstlane(threadIdx.x >> 6);
#define REFRESH() do { F.lane = lane_now(); F.tid = F.wave * 64 + F.lane; } while (0)
    REFRESH();
    F.G = gridDim.x; { const int bx = blockIdx.x; F.vcu = (F.G % 8 == 0) ? (bx % 8) * (F.G / 8) + bx / 8 : bx; }
    volatile LAS unsigned* MISC = (volatile LAS unsigned*)(F.lds + MISC_OFF);
    if (F.tid < 128) MISC[F.tid] = 0u;
    __syncthreads();
    unsigned char* ws = args.ws; float* out = args.out;
    unsigned* ctl = (unsigned*)(ws + WS_CTL);
    const int lo = args.ph_lo, hi = args.ph_hi;
    XcdBarrier bar; bar.bar = ctl + CW_BAR; bar.x = 0; bar.st = nullptr;
    if (hi - lo > 1) bar = xcd_barrier_post(ctl + CW_BAR, MISC + 8, F.tid == 0);
#define IN(k) (lo <= (k) && (k) < hi)
#define SEAM(k) do { REFRESH(); if (IN(k) && IN((k) + 1)) xcd_barrier(bar, F.tid == 0); REFRESH(); } while (0)
    bf16* Win_t = (bf16*)(ws + WS_WIN); bf16* Wout_t = (bf16*)(ws + WS_WOUT); bf16* Wup_t = (bf16*)(ws + WS_WUP); bf16* Wdn_t = (bf16*)(ws + WS_WDN);
    bf16* Wdt_t = (bf16*)(ws + WS_WDT); bf16* PWt = (bf16*)(ws + WS_PWT);
    bf16* XN1 = (bf16*)(ws + WS_A); bf16* HIN = (bf16*)(ws + WS_A); bf16* X1b = (bf16*)(ws + WS_A);
    bf16* PROJ = (bf16*)(ws + WS_B); bf16* Hb = (bf16*)(ws + WS_B + WB_H); float* UT = (float*)(ws + WS_B + WB_UT); float* UH = (float*)(ws + WS_B + WB_UH);
    float* SSP = (float*)(ws + WS_B + WB_SSP); float* SSP2 = (float*)(ws + WS_B + WB_SSP2); bf16* HS = (bf16*)(ws + WS_B + WB_HS); float* X2S = (float*)(ws + WS_B + WB_X2S);
    bf16* Y = (bf16*)(ws + WS_Y); float* DT = (float*)(ws + WS_DT); float* CDEC = (float*)(ws + WS_CDEC);
    float* X1S = (float*)(ws + WS_X1S); bf16* XN2S = (bf16*)(ws + WS_XN2S); bf16* XN1S = (bf16*)(ws + WS_XN1S);
    float* PROJS = out + OS_PROJS; float* DTS = out + OS_DTS; bf16* YS = (bf16*)(out + OS_YS);
    float* CS = out + O_YP;
    float* X1 = out + O_YP;
    const int gw = F.vcu * NWAVES + F.wave, NGW = F.G * NWAVES;
    LAS float* redl = (LAS float*)F.lds;

    if (IN(0) && MK_EN(0)) for (int rep_ = 0; rep_ <= MK_DUPK(0); ++rep_) { if (rep_) { REFRESH(); xcd_barrier(bar, F.tid == 0); REFRESH(); }
        ARG(x_prompt, 0);
        ARG(x_sample, 1);
        ARG(norm1_w, 6);
        ARG(w_in, 7);
        ARG(pool_w, 14);
        ARG(w_out, 16);
        ARG(norm2_w, 17);
        ARG(w_up, 18);
        ARG(ffn_conv_w, 19);
        ARG(ffn_conv_b, 20);
        ARG(w_down, 21);
        LAS float* scr = (LAS float*)(F.lds + F.wave * 16384);
        constexpr int I1 = 16 * 112, I2 = 16 * 16, I3 = 32 * 32, I4 = 16 * 176, I5 = 44 * 32, I6 = 32, I7 = 16, NITEMS = I1 + I2 + I3 + I4 + I5 + I6 + I7;
        for (int it = gw; it < NITEMS; it += NGW) {
            int r = it;
            if (r < I1) { transpose_item(w_in, INC, 64 * (r / 112), 32 * (r % 112), 32, Win_t, 1024, 32 * (r % 112), nullptr, scr, F.lane); continue; } r -= I1;
            if (r < I2) { transpose_item(w_in, INC, 64 * (r / 16), 3608 + 32 * (r % 16), 32, Win_t, 1024, 3584 + 32 * (r % 16), nullptr, scr, F.lane); continue; } r -= I2;
            if (r < I3) { transpose_item(w_out, 1024, 64 * (r / 32), 32 * (r % 32), 32, Wout_t, 2048, 32 * (r % 32), nullptr, scr, F.lane); continue; } r -= I3;
            if (r < I4) { const int j = 32 * (r % 176); const int drow = (j < DFF) ? 256 * (j / 128) + (j % 128) : 256 * ((j - DFF) / 128) + 128 + ((j - DFF) % 128);
                          transpose_item(w_up, UPN, 64 * (r / 176), j, 32, Wup_t, 1024, drow, norm2_w, scr, F.lane); continue; } r -= I4;
            if (r < I5) { transpose_item(w_down, 1024, 64 * (r / 32), 32 * (r % 32), 32, Wdn_t, DFF, 32 * (r % 32), nullptr, scr, F.lane); continue; } r -= I5;
            if (r < I6) { const int g = r >> 3, rr = r & 7; transpose_item(pool_w + (size_t)g * 16384, 128, 64 * (rr >> 2), 32 * (rr & 3), 32, PWt + (size_t)g * 16384, 128, 32 * (rr & 3), nullptr, scr, F.lane); continue; } r -= I6;
            transpose_item(w_in, INC, 64 * r, 3584, 24, Wdt_t, 1024, 0, nullptr, scr, F.lane);
        }
        { float* fcw = (float*)(ws + WS_FCW);
          for (int j = F.vcu * NT + F.tid; j < 4 * UPN; j += F.G * NT) fcw[j] = (j < 3 * UPN) ? ffn_conv_w[j] : ffn_conv_b[j - 3 * UPN]; }
        for (int m = gw; m < MP + NS; m += NGW) {
            if (m < MP) rms_row_to_bf16(x_prompt + (size_t)m * DM, norm1_w, XN1 + (size_t)m * DM, F.lane);
            else rms_row_to_bf16(x_sample + (size_t)(m - MP) * DM, norm1_w, XN1S + (size_t)(m - MP) * DM, F.lane);
        }
        __syncthreads();
    }
    SEAM(0);

    if (IN(1) && MK_EN(1)) for (int rep_ = 0; rep_ <= MK_DUPK(1); ++rep_) { if (rep_) { REFRESH(); xcd_barrier(bar, F.tid == 0); REFRESH(); }
        ARG(dt_bias, 10);
        const int i = F.lane & 15, g4 = F.lane >> 4;
        for (int blk = F.vcu; blk < MP / 64; blk += F.G) {
            const int mt = F.wave >> 1, nt = F.wave & 1;
            const bf16* ap = XN1 + (size_t)(blk * 64 + mt * 16 + i) * DM + 8 * g4; const bf16* bp = Wdt_t + (size_t)(nt * 16 + i) * DM + 8 * g4;
            f32x4 acc = (f32x4){0.f, 0.f, 0.f, 0.f};
#pragma unroll 8
            for (int ks = 0; ks < 32; ++ks) acc = MFMA16(*(const bf16x8*)(ap + 32 * ks), *(const bf16x8*)(bp + 32 * ks), acc);
            const int h = nt * 16 + i;
            if (h < NH) { const float bias = dt_bias[h];
#pragma unroll
                for (int r = 0; r < 4; ++r) DT[(size_t)(blk * 64 + mt * 16 + 4 * g4 + r) * 24 + h] = softplus_f(acc[r] + bias); }
        }
        for (int sl = F.vcu; sl < 256 + 2; sl += F.G) {
            f32x4 acc[8];
            const bool isdt = sl >= 256; const int n0 = isdt ? 16 * (sl - 256) : 16 * sl;
            skinny_acc<8, 1024>(XN1S, isdt ? Wdt_t : Win_t, 0, n0, F.wave, F.lane, acc);
            const f32x4 s = skinny_reduce<8>(redl, acc, F.wave, F.lane, F.tid);
            const int col = n0 + (F.tid & 15), rowb = 16 * (F.tid >> 6) + 4 * ((F.tid & 63) >> 4);
            if (!isdt) {
#pragma unroll
                for (int r = 0; r < 4; ++r) PROJS[(size_t)(rowb + r) * NPROJ + col] = s[r]; }
            else if (col < NH) { const float bias = dt_bias[col];
#pragma unroll
                for (int r = 0; r < 4; ++r) DTS[(rowb + r) * 24 + col] = softplus_f(s[r] + bias); }
        }
        __syncthreads();
        pg8::Gemm gm{XN1, Win_t, MP, NPROJ, DM}; pg8::StaticOrder S; S.init(MP, NPROJ, F.G, (int)blockIdx.x);
        pg8::EpiStoreBf16 E{PROJ, NPROJ};
        pg8::gemm_phase<pg8::EpiStoreBf16, pg8::StaticOrder, true, true>(F.lds + RING_OFF, gm, S, E, F.tid);
    }
    SEAM(1);

    if (IN(2) && MK_EN(2)) for (int rep_ = 0; rep_ <= MK_DUPK(2); ++rep_) { if (rep_) { REFRESH(); xcd_barrier(bar, F.tid == 0); REFRESH(); }
        constexpr int NU0 = 512 + 512 + 512 + 128, NUX = ((MK_P2DUP & 1) ? 512 : 0) + ((MK_P2DUP & 2) ? 512 : 0) + ((MK_P2DUP & 4) ? 512 : 0) + ((MK_P2DUP & 8) ? 128 : 0);
        for (int u0 = F.vcu; u0 < NU0 + NUX; u0 += F.G) {
            int u = u0;
            if (u >= NU0) u = (MK_P2DUP & 1) ? u - NU0 : (MK_P2DUP & 2) ? u - NU0 + 512 : (MK_P2DUP & 4) ? u - NU0 + 1024 : u - NU0 + 1536;
            if (u < 512) s1_unit(F, PROJ, DT, CS, CDEC, out + O_CONVP, u);
            else if (u < 1024) pool_unit(F, PROJ, PWt, Y, out + O_POOLP, u - 512);
            else if (u < 1536) ssm_sample_unit(F, out, u - 1024);
            else pool_sample_unit(F, out, u - 1536);
        }
    }
    SEAM(2);

    if (IN(3) && MK_EN(3)) for (int rep_ = 0; rep_ <= MK_DUPK(3); ++rep_) { if (rep_) { REFRESH(); xcd_barrier(bar, F.tid == 0); REFRESH(); }
        ARG(x_sample, 1);
        ARG(w_out, 16);
        ARG(norm2_w, 17);
        for (int it = F.vcu * NT + F.tid; it < NB * NH * 64 * 16; it += F.G * NT) {
            const int n4 = it & 15, p = (it >> 4) & 63, hh = (it >> 10) % NH, b = (it >> 10) / NH;
            f32x4 cs[16];
#pragma unroll
            for (int c = 0; c < 16; ++c) cs[c] = *(const f32x4*)(CS + ((((size_t)b * 16 + c) * NH + hh) * 64 + p) * 64 + 4 * n4);
            f32x4 h = (f32x4){0.f, 0.f, 0.f, 0.f};
#pragma unroll
            for (int c = 0; c < 16; ++c) { v2u pk; pk.x = cvt_pk_bf16(h[0], h[1]); pk.y = cvt_pk_bf16(h[2], h[3]);
                *(v2u*)(HIN + ((((size_t)b * 16 + c) * NH + hh) * 64 + p) * 64 + 4 * n4) = pk;
                h = h * CDEC[(b * 16 + c) * NH + hh] + cs[c]; }
            *(f32x4*)(out + O_SSMP + (((size_t)b * NH + hh) * 64 + p) * 64 + 4 * n4) = h;
        }
        for (int sl = F.vcu; sl < 256; sl += F.G) {
            const int rt = sl >> 6, nt = sl & 63; f32x4 acc[2];
            skinny_acc<2, 2048>(YS, Wout_t, 32 * rt, 16 * nt, F.wave, F.lane, acc);
            const f32x4 s = skinny_reduce<2>(redl, acc, F.wave, F.lane, F.tid);
            if ((F.tid >> 6) < 2) { const int col = 16 * nt + (F.tid & 15), rowb = 32 * rt + 16 * (F.tid >> 6) + 4 * ((F.tid & 63) >> 4);
#pragma unroll
                for (int r = 0; r < 4; ++r) X1S[(size_t)(rowb + r) * DM + col] = s[r] + x_sample[(size_t)(rowb + r) * DM + col]; }
        }
    }
    SEAM(3);

    if (IN(4) && MK_EN(4)) for (int rep_ = 0; rep_ <= MK_DUPK(4); ++rep_) { if (rep_) { REFRESH(); xcd_barrier(bar, F.tid == 0); REFRESH(); }
        for (int u = F.vcu; u < 512; u += F.G) s3_unit(F, PROJ, DT, HIN, Y, u);
        for (int m = gw; m < NS; m += NGW) rms_row_to_bf16(X1S + (size_t)m * DM, nullptr, XN2S + (size_t)m * DM, F.lane);
    }
    SEAM(4);

    if (IN(5) && MK_EN(5)) for (int rep_ = 0; rep_ <= MK_DUPK(5); ++rep_) { if (rep_) { REFRESH(); xcd_barrier(bar, F.tid == 0); REFRESH(); }
        ARG(x_prompt, 0);
        ARG(state_ffn, 5);
        ARG(ffn_conv_w, 19);
        ARG(ffn_conv_b, 20);
        for (int sl = F.vcu; sl < 352; sl += F.G) {
            const int rt = sl / 176, ct = sl % 176, c0 = 16 * ct, ng0 = 256 * (c0 >> 7) + (c0 & 127);
            f32x4 acc[4];
            skinny_acc<4, 1024>(XN2S, Wup_t, 64 * rt, ng0, F.wave, F.lane, acc);
            const f32x4 sg = skinny_reduce<4>(redl, acc, F.wave, F.lane, F.tid);
            skinny_acc<4, 1024>(XN2S, Wup_t, 64 * rt, ng0 + 128, F.wave, F.lane, acc);
            const f32x4 sv = skinny_reduce<4>(redl, acc, F.wave, F.lane, F.tid);
            if ((F.tid >> 6) < 4) { const int ch = c0 + (F.tid & 15), rowb = 64 * rt + 16 * (F.tid >> 6) + 4 * ((F.tid & 63) >> 4);
                const float wg0 = ffn_conv_w[ch], wg1 = ffn_conv_w[UPN + ch], wg2 = ffn_conv_w[2 * UPN + ch], bg = ffn_conv_b[ch];
                const float wv0 = ffn_conv_w[DFF + ch], wv1 = ffn_conv_w[UPN + DFF + ch], wv2 = ffn_conv_w[2 * UPN + DFF + ch], bv = ffn_conv_b[DFF + ch];
#pragma unroll
                for (int r = 0; r < 4; ++r) { const int bb = rowb + r; const float* st = state_ffn + (size_t)bb * 2 * UPN; float* fo = out + O_FFNS + (size_t)bb * 2 * UPN;
                    const float g0 = st[ch], g1 = st[UPN + ch], v0 = st[DFF + ch], v1 = st[UPN + DFF + ch];
                    const float ug = bg + wg0 * g0 + wg1 * g1 + wg2 * sg[r], uv = bv + wv0 * v0 + wv1 * v1 + wv2 * sv[r];
                    HS[(size_t)bb * DFF + ch] = f2bf(silu_f(ug) * uv);
                    fo[ch] = g1; fo[UPN + ch] = sg[r]; fo[DFF + ch] = v1; fo[UPN + DFF + ch] = sv[r]; } }
        }
        __syncthreads();
        pg8::Gemm gm{Y, Wout_t, MP, DM, DMIX}; pg8::StaticOrder S; S.init(MP, DM, F.G, (int)blockIdx.x);
        pg8::EpiResid<true> E{x_prompt, X1, X1b, SSP};
        pg8::gemm_phase<pg8::EpiResid<true>, pg8::StaticOrder, true, true>(F.lds + RING_OFF, gm, S, E, F.tid);
    }
    SEAM(5);

    if (IN(6) && MK_EN(6)) for (int rep_ = 0; rep_ <= MK_DUPK(6); ++rep_) { if (rep_) { REFRESH(); xcd_barrier(bar, F.tid == 0); REFRESH(); }
        ARG(w_down, 21);
        for (int sl = F.vcu; sl < 256; sl += F.G) {
            const int rt = sl >> 6, nt = sl & 63; f32x4 acc[2];
            skinny_acc<2, 2816>(HS, Wdn_t, 32 * rt, 16 * nt, F.wave, F.lane, acc);
            const f32x4 s = skinny_reduce<2>(redl, acc, F.wave, F.lane, F.tid);
            if ((F.tid >> 6) < 2) { const int col = 16 * nt + (F.tid & 15), rowb = 32 * rt + 16 * (F.tid >> 6) + 4 * ((F.tid & 63) >> 4);
#pragma unroll
                for (int r = 0; r < 4; ++r) X2S[(size_t)(rowb + r) * DM + col] = s[r] + X1S[(size_t)(rowb + r) * DM + col]; }
        }
        __syncthreads();
        pg8::Gemm gm{X1b, Wup_t, MP, UPN, DM}; pg8::UpOrder S; S.init(MP, UPN, F.G, (int)blockIdx.x);
        S.fcw = (const float*)(ws + WS_FCW); S.lds = F.lds; S.wid = F.wave; S.k_ = 0;
        { pg8::Unit u; LAS float* RS = (LAS float*)(F.lds + pg8::UP_RS);
          for (int ui = 0; ui < 8 && S.next(ui, u); ++ui)
              for (int r = F.tid; r < 256; r += NT) { const f32x4* pp = (const f32x4*)(SSP + (size_t)(u.pm * 256 + r) * 16); const f32x4 p0 = pp[0], p1 = pp[1], p2 = pp[2], p3 = pp[3];
                  const float sq = ((p0[0] + p0[1]) + (p0[2] + p0[3])) + ((p1[0] + p1[1]) + (p1[2] + p1[3])) + ((p2[0] + p2[1]) + (p2[2] + p2[3])) + ((p3[0] + p3[1]) + (p3[2] + p3[3]));
                  RS[ui * 256 + r] = __builtin_amdgcn_rsqf(sq * (1.0f / 1024.0f) + EPS); } }
        __syncthreads();
#if MK_P6DUP
        { pg8::StaticOrder S0; S0.init(MP, UPN, F.G, (int)blockIdx.x); pg8::EpiNull E0{(float*)(ws + WS_Y)};
          pg8::gemm_phase<pg8::EpiNull, pg8::StaticOrder, true, true>(F.lds + RING_OFF, gm, S0, E0, F.tid); REFRESH(); xcd_barrier(bar, F.tid == 0); REFRESH(); }
#endif
        typedef pg8::EpiUp<WS_B + WB_H, WS_B + WB_UT, WS_B + WB_UH> EpiUpT;
        EpiUpT E{ws, out + O_FFNP, F.lds, 0};
        pg8::gemm_phase<EpiUpT, pg8::UpOrder, true, true>(F.lds + RING_OFF, gm, S, E, F.tid);
    }
    SEAM(6);

    if (IN(7) && MK_EN(7)) for (int rep_ = 0; rep_ <= MK_DUPK(7); ++rep_) { if (rep_) { REFRESH(); xcd_barrier(bar, F.tid == 0); REFRESH(); }
        ARG(ffn_conv_w, 19);
        ARG(ffn_conv_b, 20);
        ARG(final_norm_w, 22);
        for (int m = gw; m < NS; m += NGW) {
            const f32x4* xr = (const f32x4*)(X2S + (size_t)m * DM) + F.lane; f32x4 v[4]; float s = 0.f;
#pragma unroll
            for (int j = 0; j < 4; ++j) { v[j] = xr[64 * j]; s += (v[j][0] * v[j][0] + v[j][1] * v[j][1]) + (v[j][2] * v[j][2] + v[j][3] * v[j][3]); }
            const float rs = 1.0f / sqrtf(wave_sum(s) * (1.0f / 1024.0f) + EPS);
            f32x4* yo = (f32x4*)(out + O_YS + (size_t)m * DM) + F.lane;
#pragma unroll
            for (int j = 0; j < 4; ++j) yo[64 * j] = v[j] * rs * ((const f32x4*)final_norm_w)[F.lane + 64 * j];
        }
        pg8::StaticOrder S; S.init(MP, DM, F.G, (int)blockIdx.x);
        { pg8::Unit u;
          for (int ui = 0; S.next(ui, u); ++ui) { const int pm = u.pm; if ((pm & 7) == 0) continue;
            for (int j = F.tid; j < DFF; j += NT) { const int gi = 256 * (j >> 7) + (j & 127), vi = gi + 128;
                const float* t0 = UT + (size_t)(pm - 1) * 2 * UPN; const float* h0 = UH + (size_t)pm * 2 * UPN;
                const float gm2 = t0[gi], gm1 = t0[UPN + gi], g0 = h0[gi], g1 = h0[UPN + gi];
                const float vm2 = t0[vi], vm1 = t0[UPN + vi], v0 = h0[vi], v1 = h0[UPN + vi];
                const float wg0 = ffn_conv_w[j], wg1 = ffn_conv_w[UPN + j], wg2 = ffn_conv_w[2 * UPN + j], bg = ffn_conv_b[j];
                const float wv0 = ffn_conv_w[DFF + j], wv1 = ffn_conv_w[UPN + DFF + j], wv2 = ffn_conv_w[2 * UPN + DFF + j], bv = ffn_conv_b[DFF + j];
                const float ug0 = bg + wg0 * gm2 + wg1 * gm1 + wg2 * g0, ug1 = bg + wg0 * gm1 + wg1 * g0 + wg2 * g1;
                const float uv0 = bv + wv0 * vm2 + wv1 * vm1 + wv2 * v0, uv1 = bv + wv0 * vm1 + wv1 * v0 + wv2 * v1;
                Hb[(size_t)(256 * pm) * DFF + j] = f2bf(silu_f(ug0) * uv0); Hb[(size_t)(256 * pm + 1) * DFF + j] = f2bf(silu_f(ug1) * uv1); } } }
        VM_WAIT(); __syncthreads();
        pg8::Gemm gm{Hb, Wdn_t, MP, DM, DFF};
#if MK_P7DUP
        { pg8::EpiResid<false> E0{X1, (float*)(ws + WS_Y), nullptr, SSP2}; pg8::gemm_phase<pg8::EpiResid<false>, pg8::StaticOrder, true, true>(F.lds + RING_OFF, gm, S, E0, F.tid); REFRESH(); xcd_barrier(bar, F.tid == 0); REFRESH(); }
#endif
        pg8::EpiResid<false> E{X1, X1, nullptr, SSP2};
        pg8::gemm_phase<pg8::EpiResid<false>, pg8::StaticOrder, true, true>(F.lds + RING_OFF, gm, S, E, F.tid);
    }
    SEAM(7);

    if (IN(8) && MK_EN(8)) for (int rep_ = 0; rep_ <= MK_DUPK(8); ++rep_) { if (rep_) { REFRESH(); xcd_barrier(bar, F.tid == 0); REFRESH(); }
        ARG(final_norm_w, 22);
#if MK_P8DUP
        for (int m = gw; m < MP; m += NGW) {
            f32x4* xr = (f32x4*)(out + O_YP + (size_t)m * DM) + F.lane; f32x4* xw = (f32x4*)((float*)(ws + WS_Y) + (size_t)m * DM) + F.lane; f32x4 v[4];
#pragma unroll
            for (int j = 0; j < 4; ++j) v[j] = xr[64 * j];
            const f32x4* pp = (const f32x4*)(SSP2 + (size_t)m * 16); const f32x4 p0 = pp[0], p1 = pp[1], p2 = pp[2], p3 = pp[3];
            const float s = ((p0[0] + p0[1]) + (p0[2] + p0[3])) + ((p1[0] + p1[1]) + (p1[2] + p1[3])) + ((p2[0] + p2[1]) + (p2[2] + p2[3])) + ((p3[0] + p3[1]) + (p3[2] + p3[3]));
            const float rs = 1.0f / sqrtf(s * (1.0f / 1024.0f) + EPS);
#pragma unroll
            for (int j = 0; j < 4; ++j) xw[64 * j] = v[j] * rs * ((const f32x4*)final_norm_w)[F.lane + 64 * j];
        }
        REFRESH(); xcd_barrier(bar, F.tid == 0); REFRESH();
#endif
        for (int m = gw; m < MP; m += NGW) {
            f32x4* xr = (f32x4*)(out + O_YP + (size_t)m * DM) + F.lane; f32x4 v[4];
#pragma unroll
            for (int j = 0; j < 4; ++j) v[j] = xr[64 * j];
            const f32x4* pp = (const f32x4*)(SSP2 + (size_t)m * 16); const f32x4 p0 = pp[0], p1 = pp[1], p2 = pp[2], p3 = pp[3];
            const float s = ((p0[0] + p0[1]) + (p0[2] + p0[3])) + ((p1[0] + p1[1]) + (p1[2] + p1[3])) + ((p2[0] + p2[1]) + (p2[2] + p2[3])) + ((p3[0] + p3[1]) + (p3[2] + p3[3]));
            const float rs = 1.0f / sqrtf(s * (1.0f / 1024.0f) + EPS);
#pragma unroll
            for (int j = 0; j < 4; ++j) xr[64 * j] = v[j] * rs * ((const f32x4*)final_norm_w)[F.lane + 64 * j];
        }
    }
#undef IN
#undef SEAM
}
}

#ifndef MK_PER_PHASE
#define MK_PER_PHASE 0
#endif
extern "C" void kernel_launch(void* const* d_in, const int* in_sizes, int n_in, void* d_out, int out_size, void* d_ws, size_t ws_size, hipStream_t stream) {
    using namespace mk;
    static int grid = 0;
    if (grid == 0) {
        if (n_in != 23 || in_sizes[0] != MP * DM || out_size != (int)O_END || ws_size < WS_END) {
            fprintf(stderr, "kernel_launch: unexpected problem (n_in %d, in0 %d, out %d, ws %zu); nothing launched\n", n_in, n_in > 0 ? in_sizes[0] : -1, out_size, ws_size); grid = -1; return; }
        int dev = 0, cus = 0, per_cu = 0;
        if (hipGetDevice(&dev) != hipSuccess || hipDeviceGetAttribute(&cus, hipDeviceAttributeMultiprocessorCount, dev) != hipSuccess) { fprintf(stderr, "kernel_launch: device query failed\n"); grid = -1; return; }
#if MK_PER_PHASE
        const void* fns[9] = {(const void*)mk_fwd<1>, (const void*)mk_fwd<2>, (const void*)mk_fwd<4>, (const void*)mk_fwd<8>, (const void*)mk_fwd<16>, (const void*)mk_fwd<32>, (const void*)mk_fwd<64>, (const void*)mk_fwd<128>, (const void*)mk_fwd<256>};
        const int nfn = 9;
#else
        const void* fns[1] = {(const void*)mk_fwd<0x1FF>};
        const int nfn = 1;
#endif
        for (int i = 0; i < nfn; ++i)
            if (hipFuncSetAttribute(fns[i], hipFuncAttributeMaxDynamicSharedMemorySize, LDS_BYTES) != hipSuccess) { fprintf(stderr, "kernel_launch: hipFuncSetAttribute(%d B LDS) failed\n", LDS_BYTES); grid = -1; return; }
        if (hipOccupancyMaxActiveBlocksPerMultiprocessor(&per_cu, fns[0], NT, LDS_BYTES) != hipSuccess || per_cu < 1) {
            fprintf(stderr, "kernel_launch: occupancy query reports %d workgroups per CU; nothing launched\n", per_cu); (void)hipGetLastError(); grid = -1; return; }
        grid = cus;
    }
    if (grid < 0) return;
    if (hipMemsetAsync((char*)d_ws + WS_CTL, 0, CTL_BYTES, stream) != hipSuccess) { fprintf(stderr, "kernel_launch: memset failed\n"); return; }
    Args a{};
    for (int i = 0; i < 23; ++i) a.in[i] = (const float*)d_in[i];
    a.out = (float*)d_out; a.ws = (unsigned char*)d_ws;
#if MK_PER_PHASE
#define MK_LAUNCH(p) do { a.ph_lo = p; a.ph_hi = p + 1; hipLaunchKernelGGL(mk_fwd<(1 << p)>, dim3(grid), dim3(NT), LDS_BYTES, stream, a); } while (0)
    MK_LAUNCH(0); MK_LAUNCH(1); MK_LAUNCH(2); MK_LAUNCH(3); MK_LAUNCH(4); MK_LAUNCH(5); MK_LAUNCH(6); MK_LAUNCH(7); MK_LAUNCH(8);
#else
    a.ph_lo = 0; a.ph_hi = NPHASE;
    hipLaunchKernelGGL(mk_fwd<0x1FF>, dim3(grid), dim3(NT), LDS_BYTES, stream, a);
#endif
    const hipError_t le = hipPeekAtLastError();
    if (le != hipSuccess) fprintf(stderr, "kernel_launch: launch failed: %s\n", hipGetErrorName(le));
}
```

```cpp
#include <hip/hip_runtime.h>
#include <cstdio>
#include <cstdint>
namespace pg8 {
#define PG8_LAS __attribute__((address_space(3)))
typedef unsigned short bf16_t;
typedef short bf16x8 __attribute__((ext_vector_type(8)));
typedef float f32x4 __attribute__((ext_vector_type(4)));
typedef unsigned u32x4 __attribute__((ext_vector_type(4)));
constexpr int BM = 256, BK = 64, HALF = 128, HTB = HALF * BK * 2  , STAGE_BYTES = 8 * HTB, NXCD = 8, WGM = 8;

__host__ __device__ __forceinline__ int lds_byte(int r, int c) { const int st = (r >> 4) * 2 + (c >> 5), rr = r & 15, cc = c & 31, ob = rr * 64 + cc * 2; return st * 1024 + (ob ^ (((ob >> 9) & 1) << 5)); }
__host__ __device__ __forceinline__ void stage_rc(int b, int& R, int& C) { const int st = b / 1024, sb = b % 1024, swz = sb ^ (((sb >> 9) & 1) << 5); R = (st >> 1) * 16 + swz / 64; C = (st & 1) * 32 + (swz % 64) / 2; }
__host__ __device__ __forceinline__ int perm32(int rho) { const int n = rho >> 4, i = rho & 15; return 8 * (i >> 2) + 4 * n + (i & 3); }

struct Unit { int pm, pn; };
struct Gemm { const bf16_t* A; const bf16_t* Bt; int M, N, K; };

struct StaticOrder {
    int nM, nN, nwg, G, c;
    __host__ __device__ void init(int M, int N, int G_, int c_) { nM = M / BM; nN = N / BM; nwg = nM * nN; G = G_; c = c_; }
    __host__ __device__ bool next(int i, Unit& u) const {
        const long L = (long)i * G + c; if (L >= nwg) return false;
        int wgid = (int)L; { const int q = nwg / NXCD, r = nwg % NXCD, xcd = wgid % NXCD, off = wgid / NXCD; wgid = (xcd < r ? xcd * (q + 1) : r * (q + 1) + (xcd - r) * q) + off; }
        const int nig = WGM * nN, gid = wgid / nig, fm = gid * WGM, gsz = (nM - fm) < WGM ? (nM - fm) : WGM;
        u.pm = fm + ((wgid % nig) % gsz); u.pn = (wgid % nig) / gsz; return true;
    }
    __device__ __forceinline__ void a_ready(const Unit&) const {}
    __device__ __forceinline__ void done(const Unit&) const {}
};

__device__ __forceinline__ unsigned cvt_pk_bf16(float lo, float hi) { unsigned r; asm volatile("v_cvt_pk_bf16_f32 %0, %1, %2" : "=v"(r) : "v"(lo), "v"(hi)); return r; }
typedef float f32x2 __attribute__((ext_vector_type(2)));
typedef unsigned u32x2 __attribute__((ext_vector_type(2)));
__device__ __forceinline__ float silu_f(float x) { return x * __builtin_amdgcn_rcpf(1.0f + __expf(-x)); }
__device__ __forceinline__ float dpp_ror1(float v) { return __builtin_bit_cast(float, __builtin_amdgcn_update_dpp(0, __builtin_bit_cast(int, v), 0x121, 0xf, 0xf, false)); }
__device__ __forceinline__ float dpp_ror2(float v) { return __builtin_bit_cast(float, __builtin_amdgcn_update_dpp(0, __builtin_bit_cast(int, v), 0x122, 0xf, 0xf, false)); }

struct EpiStoreBf16 {
    static constexpr bool PERM = true, AFTER_DRAIN = false;
    bf16_t* O; int ldc;
    __device__ __forceinline__ void operator()(f32x4 (&acc)[2][2][4][2], const Unit& u, int wr, int wc, int fr, int fq) const {
        const int row0 = u.pm * BM + wr * 64 + fr, col0 = u.pn * BM + wc * 32 + 8 * fq;
#pragma unroll
        for (int ai = 0; ai < 2; ++ai)
#pragma unroll
            for (int m = 0; m < 4; ++m) { bf16_t* rowp = O + (size_t)(row0 + ai * HALF + m * 16) * ldc + col0;
#pragma unroll
                for (int bj = 0; bj < 2; ++bj) { const f32x4 v0 = acc[ai][bj][m][0], v1 = acc[ai][bj][m][1];
                    u32x4 w; w.x = cvt_pk_bf16(v0[0], v0[1]); w.y = cvt_pk_bf16(v0[2], v0[3]); w.z = cvt_pk_bf16(v1[0], v1[1]); w.w = cvt_pk_bf16(v1[2], v1[3]);
                    *(u32x4*)(rowp + bj * HALF) = w; } }
    }
};

template <int MODE> struct EpiResid {
    static constexpr bool PERM = false, AFTER_DRAIN = false;
    const void* xin; void* xo; float* ssp;
    __device__ __forceinline__ void operator()(f32x4 (&acc)[2][2][4][2], const Unit& u, int wr, int wc, int fr, int fq) const {
        const int row0 = u.pm * BM + wr * 64 + fr, col0 = u.pn * BM + wc * 32 + 4 * fq;
#pragma unroll
        for (int ai = 0; ai < 2; ++ai)
#pragma unroll
            for (int m = 0; m < 4; ++m) { const int row = row0 + ai * HALF + m * 16; float ss = 0.f;
#pragma unroll
                for (int bj = 0; bj < 2; ++bj)
#pragma unroll
                    for (int n = 0; n < 2; ++n) { const size_t off = (size_t)row * 1024 + col0 + bj * HALF + n * 16; f32x4 v;
                        if (MODE == 0) v = acc[ai][bj][m][n] + *(const f32x4*)((const float*)xin + off);
                        else { const u32x2 rb = *(const u32x2*)((const bf16_t*)xin + off);
                               v = acc[ai][bj][m][n] + (f32x4){__uint_as_float(rb.x << 16), __uint_as_float(rb.x & 0xffff0000u), __uint_as_float(rb.y << 16), __uint_as_float(rb.y & 0xffff0000u)}; }
                        ss += (v[0] * v[0] + v[1] * v[1]) + (v[2] * v[2] + v[3] * v[3]);
                        if (MODE == 0) { u32x2 w; w.x = cvt_pk_bf16(v[0], v[1]); w.y = cvt_pk_bf16(v[2], v[3]); *(u32x2*)((bf16_t*)xo + off) = w; }
                        else *(f32x4*)((float*)xo + off) = v; }
                ss += __shfl_xor(ss, 16); ss += __shfl_xor(ss, 32);
                if (fq == 0) ssp[(size_t)row * 16 + u.pn * 4 + wc] = ss; }
    }
};

struct EpiNull {
    static constexpr bool PERM = true, AFTER_DRAIN = false; float* dummy;
    __device__ __forceinline__ void operator()(f32x4 (&acc)[2][2][4][2], const Unit& u, int wr, int wc, int fr, int fq) const {
        f32x4 s = (f32x4){0.f, 0.f, 0.f, 0.f};
#pragma unroll
        for (int ai = 0; ai < 2; ++ai)
#pragma unroll
            for (int bj = 0; bj < 2; ++bj)
#pragma unroll
                for (int m = 0; m < 4; ++m)
#pragma unroll
                    for (int n = 0; n < 2; ++n) s += acc[ai][bj][m][n];
        dummy[(size_t)(u.pm * 22 + u.pn) * 512 + (wr * 4 + wc) * 64 + fq * 16 + fr] = (s[0] + s[1]) + (s[2] + s[3]);
    }
};
constexpr int UP_EX = 131072, UP_WB = UP_EX + 8192, UP_RS = UP_WB + 8192;
struct UpOrder : StaticOrder {
    const float* fcw; PG8_LAS unsigned char* lds; int wid; mutable int k_;
    __device__ __forceinline__ void a_ready(const Unit& u) const {
        if (wid < 4) { int l; asm volatile("v_mbcnt_lo_u32_b32 %0, -1, 0\n\tv_mbcnt_hi_u32_b32 %0, -1, %0" : "=v"(l));
            const int col = (l < 32) ? 128 * u.pn + 4 * l : 2816 + 128 * u.pn + 4 * (l - 32);
            __builtin_amdgcn_global_load_lds((const unsigned*)(fcw + wid * 5632 + col), (PG8_LAS unsigned*)(lds + UP_WB + (k_ & 1) * 4096 + wid * 1024), 16, 0, 0); }
        ++k_;
    }
};
template <size_t OFF_H, size_t OFF_UT, size_t OFF_UH> struct EpiUp {
    static constexpr bool PERM = true, AFTER_DRAIN = false;
    unsigned char* ws; float* ffn_out; PG8_LAS unsigned char* lds; mutable int ui_;
    __device__ __forceinline__ void operator()(f32x4 (&acc)[2][2][4][2], const Unit& u, int wr, int wc, int fr_, int fq_) const {
        int t_; asm volatile("v_mbcnt_lo_u32_b32 %0, -1, 0\n\tv_mbcnt_hi_u32_b32 %0, -1, %0" : "=v"(t_)); const int fr = t_ & 15, fq = (t_ >> 4) & 3;
        bf16_t* H = (bf16_t*)(ws + OFF_H); float* UT = (float*)(ws + OFF_UT); float* UH = (float*)(ws + OFF_UH);
        PG8_LAS float* ex = (PG8_LAS float*)(lds + UP_EX); const PG8_LAS float* W = (const PG8_LAS float*)(lds + UP_WB + (ui_ & 1) * 4096); const PG8_LAS float* RS = (const PG8_LAS float*)(lds + UP_RS + ui_ * 1024);
        ++ui_;
        const int row0 = u.pm * BM + wr * 64 + fr;
        const int colt = wc * 32 + 8 * fq;
#pragma unroll
        for (int ai = 0; ai < 2; ++ai)
#pragma unroll
            for (int m = 0; m < 4; ++m) { const float rs = RS[ai * HALF + wr * 64 + m * 16 + fr];
#pragma unroll
                for (int bj = 0; bj < 2; ++bj)
#pragma unroll
                    for (int n = 0; n < 2; ++n) acc[ai][bj][m][n] = acc[ai][bj][m][n] * rs; }
        if (fr >= 14) {
#pragma unroll
            for (int ai = 0; ai < 2; ++ai) { const int blk = 2 * ai + wr;
#pragma unroll
                for (int bj = 0; bj < 2; ++bj)
#pragma unroll
                    for (int n = 0; n < 2; ++n) { const int col = bj * HALF + colt + 4 * n; const f32x4 v = acc[ai][bj][3][n];
                        *(PG8_LAS f32x4*)(ex + (blk * 2 + (fr - 14)) * 256 + col) = v;
                        if (blk == 3) { *(f32x4*)(UT + ((size_t)u.pm * 2 + (fr - 14)) * 5632 + u.pn * 256 + col) = v;
                            if ((u.pm & 7) == 7) *(f32x4*)(ffn_out + ((size_t)(u.pm >> 3) * 2 + (fr - 14)) * 5632 + bj * 2816 + u.pn * 128 + colt + 4 * n) = v; } } }
        }
        if (fr < 2 && wr == 0) {
#pragma unroll
            for (int bj = 0; bj < 2; ++bj)
#pragma unroll
                for (int n = 0; n < 2; ++n) *(f32x4*)(UH + ((size_t)u.pm * 2 + fr) * 5632 + u.pn * 256 + bj * HALF + colt + 4 * n) = acc[0][bj][0][n];
        }
        asm volatile("s_waitcnt lgkmcnt(0)" ::: "memory"); __builtin_amdgcn_s_barrier(); asm volatile("" ::: "memory");
#pragma unroll
        for (int ai = 0; ai < 2; ++ai) { const int blk = 2 * ai + wr;
#pragma unroll
            for (int n = 0; n < 2; ++n) {
#pragma unroll
                for (int bj = 0; bj < 2; ++bj) { const int col = bj * HALF + colt + 4 * n; asm volatile("" ::: "memory");
                    const f32x4 w0 = *(const PG8_LAS f32x4*)(W + col), w1 = *(const PG8_LAS f32x4*)(W + 256 + col), w2 = *(const PG8_LAS f32x4*)(W + 512 + col), bb = *(const PG8_LAS f32x4*)(W + 768 + col);
                    f32x4 vprev = (f32x4){0.f, 0.f, 0.f, 0.f};
                    if (blk > 0 && fr >= 14) vprev = *(const PG8_LAS f32x4*)(ex + ((blk - 1) * 2 + (fr - 14)) * 256 + col);
#pragma unroll
                    for (int m = 3; m >= 0; --m) { const f32x4 cur = acc[ai][bj][m][n]; const f32x4 prv = (m > 0) ? acc[ai][bj][m - 1][n] : vprev; f32x4 o;
#pragma unroll
                        for (int e = 0; e < 4; ++e) { const float t1 = (fr == 15) ? prv[e] : cur[e], t2 = (fr >= 14) ? prv[e] : cur[e];
                            o[e] = bb[e] + w0[e] * dpp_ror2(t2) + w1[e] * dpp_ror1(t1) + w2[e] * cur[e]; }
                        acc[ai][bj][m][n] = o; } }
#pragma unroll
                for (int m = 0; m < 4; ++m) { const f32x4 g = acc[ai][0][m][n], v = acc[ai][1][m][n]; f32x4 h;
#pragma unroll
                    for (int e = 0; e < 4; ++e) h[e] = silu_f(g[e]) * v[e];
                    acc[ai][0][m][n] = h; asm volatile("" : "+v"(acc[ai][0][m][n])); } }
#pragma unroll
            for (int m = 0; m < 4; ++m) { const f32x4 h0 = acc[ai][0][m][0], h1 = acc[ai][0][m][1];
                u32x4 w; w.x = cvt_pk_bf16(h0[0], h0[1]); w.y = cvt_pk_bf16(h0[2], h0[3]); w.z = cvt_pk_bf16(h1[0], h1[1]); w.w = cvt_pk_bf16(h1[2], h1[3]);
                *(u32x4*)(H + (size_t)(row0 + ai * HALF + m * 16) * 2816 + u.pn * 128 + colt) = w; } }
    }
};
template <class Epi, class Sched, bool ALIGN_EPI = false, bool SP2 = false>
__device__ __forceinline__ void gemm_phase(PG8_LAS unsigned char* lds, const Gemm g, const Sched& S, const Epi& E, const int tid) {
    const int wid = __builtin_amdgcn_readfirstlane(tid >> 6), lane = tid & 63, wr = wid >> 2, wc = wid & 3, fr = lane & 15, fq = lane >> 4;
    const int K = g.K, nt = K / BK;
    unsigned voffA[2], voffB[2];
#pragma unroll
    for (int i = 0; i < 2; ++i) { int R, C; stage_rc(tid * 16 + i * 8192, R, C); const int Rb = Epi::PERM ? ((R & ~31) + perm32(R & 31)) : R;
        voffA[i] = (unsigned)(R * K + C) * 2u; voffB[i] = (unsigned)(Rb * K + C) * 2u; }
    const size_t kstep = (size_t)(BK * 2);
    const size_t hstep = (size_t)HALF * K * 2;
    const size_t tstep = 2 * hstep;
    const unsigned ldsw = (unsigned)wid * 1024u;
    const int aoff = lds_byte(wr * 64 + fr, fq * 8), boff = lds_byte(wc * 32 + fr, fq * 8);
#define PG8_SA(b, h) (((b) * 2 + (h)) * HTB)
#define PG8_SB(b, h) ((4 + (b) * 2 + (h)) * HTB)
#define PG8_STAGE(bufoff, gbase, voff) do { _Pragma("unroll") for (int _i = 0; _i < 2; ++_i) \
        __builtin_amdgcn_global_load_lds((const unsigned*)((const char*)(gbase) + (voff)[_i]), (PG8_LAS unsigned*)(lds + (bufoff) + ldsw + _i * 8192), 16, 0, 0); } while (0)
#define PG8_LDA(dst, b, h) do { _Pragma("unroll") for (int m = 0; m < 4; ++m) _Pragma("unroll") for (int k = 0; k < 2; ++k) dst[m][k] = *(const PG8_LAS bf16x8*)(lds + PG8_SA(b, h) + aoff + m * 2048 + k * 1024); } while (0)
#define PG8_LDB(dst, b, h) do { _Pragma("unroll") for (int n = 0; n < 2; ++n) _Pragma("unroll") for (int k = 0; k < 2; ++k) dst[n][k] = *(const PG8_LAS bf16x8*)(lds + PG8_SB(b, h) + boff + n * 2048 + k * 1024); } while (0)
#define PG8_MMA(ai, bj, At, Bt) do { __builtin_amdgcn_s_setprio(1); _Pragma("unroll") for (int m = 0; m < 4; ++m) _Pragma("unroll") for (int n = 0; n < 2; ++n) _Pragma("unroll") for (int k = 0; k < 2; ++k) \
        acc[ai][bj][m][n] = __builtin_amdgcn_mfma_f32_16x16x32_bf16(Bt[n][k], At[m][k], acc[ai][bj][m][n], 0, 0, 0); __builtin_amdgcn_s_setprio(0); } while (0)
#define PG8_WAIT_V(n) asm volatile("s_waitcnt vmcnt(" #n ")" ::: "memory")
#define PG8_WAIT_L(n) asm volatile("s_waitcnt lgkmcnt(" #n ")" ::: "memory")
#define PG8_BAR __builtin_amdgcn_s_barrier()
#define PG8_SCHED __builtin_amdgcn_sched_barrier(0)
    Unit cur, nxt; int ui = 0;
    if (!S.next(0, cur)) return;
    f32x4 acc[2][2][4][2];
#pragma unroll
    for (int a = 0; a < 2; ++a)
#pragma unroll
        for (int b = 0; b < 2; ++b)
#pragma unroll
            for (int m = 0; m < 4; ++m)
#pragma unroll
                for (int n = 0; n < 2; ++n) acc[a][b][m][n] = (f32x4){0.f, 0.f, 0.f, 0.f};
    bf16x8 At[4][2], B0[2][2], B1[2][2];
    const char* cA = (const char*)g.A + (size_t)cur.pm * tstep; const char* cB = (const char*)g.Bt + (size_t)cur.pn * tstep;
    S.a_ready(cur);
    if constexpr (SP2) {
        PG8_STAGE(PG8_SB(0, 0), cB, voffB); PG8_STAGE(PG8_SB(0, 1), cB + hstep, voffB); PG8_STAGE(PG8_SA(0, 0), cA, voffA); PG8_STAGE(PG8_SA(0, 1), cA + hstep, voffA);
        if (wr == 1) PG8_BAR;
        PG8_WAIT_V(2); PG8_BAR;
        PG8_STAGE(PG8_SB(1, 0), cB + kstep, voffB); PG8_STAGE(PG8_SA(1, 0), cA + kstep, voffA); PG8_STAGE(PG8_SB(1, 1), cB + hstep + kstep, voffB);
        PG8_WAIT_V(6); PG8_BAR;
    } else {
        PG8_STAGE(PG8_SB(0, 0), cB, voffB); PG8_STAGE(PG8_SA(0, 0), cA, voffA); PG8_STAGE(PG8_SB(0, 1), cB + hstep, voffB); PG8_STAGE(PG8_SA(0, 1), cA + hstep, voffA);
        if (wr == 1) PG8_BAR;
        PG8_WAIT_V(4); PG8_BAR;
        PG8_STAGE(PG8_SB(1, 0), cB + kstep, voffB); PG8_STAGE(PG8_SA(1, 0), cA + kstep, voffA); PG8_STAGE(PG8_SB(1, 1), cB + hstep + kstep, voffB);
        PG8_WAIT_V(6); PG8_BAR;
    }
    for (;;) {
        const bool has_next = S.next(ui + 1, nxt);
        const char* nA = has_next ? (const char*)g.A + (size_t)nxt.pm * tstep : cA; const char* nB = has_next ? (const char*)g.Bt + (size_t)nxt.pn * tstep : cB;
        for (int t = 0; t < nt; t += 2) {
            const bool last = (t == nt - 2);
            const char* a1 = cA + (size_t)(t + 1) * kstep;
            const char* a2 = last ? nA : cA + (size_t)(t + 2) * kstep; const char* b2 = last ? nB : cB + (size_t)(t + 2) * kstep;
            const char* a3 = a2 + kstep; const char* b3 = b2 + kstep;
            if (last && has_next) S.a_ready(nxt);
            if constexpr (SP2) {
            PG8_LDB(B0, 0, 0); PG8_LDB(B1, 0, 1); PG8_SCHED; PG8_LDA(At, 0, 0); PG8_STAGE(PG8_SA(1, 1), a1 + hstep, voffA);
            PG8_WAIT_V(8); PG8_WAIT_L(0); PG8_BAR; PG8_MMA(0, 0, At, B0); PG8_MMA(0, 1, At, B1); PG8_BAR; PG8_SCHED;
            PG8_LDA(At, 0, 1); PG8_STAGE(PG8_SB(0, 0), b2, voffB); PG8_STAGE(PG8_SB(0, 1), b2 + hstep, voffB); PG8_STAGE(PG8_SA(0, 0), a2, voffA);
            PG8_WAIT_V(8); PG8_WAIT_L(0); PG8_BAR; PG8_MMA(1, 0, At, B0); PG8_MMA(1, 1, At, B1); PG8_BAR; PG8_SCHED;
            PG8_LDB(B0, 1, 0); PG8_LDB(B1, 1, 1); PG8_SCHED; PG8_LDA(At, 1, 0); PG8_STAGE(PG8_SA(0, 1), a2 + hstep, voffA);
            PG8_WAIT_V(8); PG8_WAIT_L(0); PG8_BAR; PG8_MMA(0, 0, At, B0); PG8_MMA(0, 1, At, B1); PG8_BAR; PG8_SCHED;
            PG8_LDA(At, 1, 1); PG8_STAGE(PG8_SB(1, 0), b3, voffB); PG8_STAGE(PG8_SB(1, 1), b3 + hstep, voffB); PG8_STAGE(PG8_SA(1, 0), a3, voffA);
            PG8_WAIT_V(8); PG8_WAIT_L(0); PG8_BAR; PG8_MMA(1, 0, At, B0); PG8_MMA(1, 1, At, B1); PG8_BAR; PG8_SCHED;
            } else {
            PG8_LDB(B0, 0, 0); PG8_SCHED; PG8_LDA(At, 0, 0); PG8_STAGE(PG8_SA(1, 1), a1 + hstep, voffA);
            PG8_WAIT_L(8); PG8_BAR; PG8_WAIT_L(0); PG8_MMA(0, 0, At, B0); PG8_BAR; PG8_SCHED;
            PG8_LDB(B1, 0, 1); PG8_STAGE(PG8_SB(0, 0), b2, voffB);
            PG8_BAR; PG8_WAIT_L(0); PG8_MMA(0, 1, At, B1); PG8_BAR;
            PG8_LDA(At, 0, 1); PG8_STAGE(PG8_SA(0, 0), a2, voffA);
            PG8_BAR; PG8_WAIT_L(0); PG8_MMA(1, 0, At, B0); PG8_BAR; PG8_SCHED;
            PG8_STAGE(PG8_SB(0, 1), b2 + hstep, voffB);
            PG8_WAIT_V(6); PG8_BAR; PG8_MMA(1, 1, At, B1); PG8_BAR;
            PG8_LDB(B0, 1, 0); PG8_SCHED; PG8_LDA(At, 1, 0); PG8_STAGE(PG8_SA(0, 1), a2 + hstep, voffA);
            PG8_WAIT_L(8); PG8_BAR; PG8_WAIT_L(0); PG8_MMA(0, 0, At, B0); PG8_BAR; PG8_SCHED;
            PG8_LDB(B1, 1, 1); PG8_STAGE(PG8_SB(1, 0), b3, voffB);
            PG8_BAR; PG8_WAIT_L(0); PG8_MMA(0, 1, At, B1); PG8_BAR;
            PG8_LDA(At, 1, 1); PG8_STAGE(PG8_SA(1, 0), a3, voffA);
            PG8_BAR; PG8_WAIT_L(0); PG8_MMA(1, 0, At, B0); PG8_BAR; PG8_SCHED;
            PG8_STAGE(PG8_SB(1, 1), b3 + hstep, voffB);
            PG8_WAIT_V(6); PG8_BAR; PG8_MMA(1, 1, At, B1); PG8_BAR;
            }
        }
        if constexpr (ALIGN_EPI) { if (wr == 0) PG8_BAR; }
        if constexpr (!Epi::AFTER_DRAIN) { E(acc, cur, wr, wc, fr, fq); S.done(cur); }
        if (!has_next) break;
#pragma unroll
        for (int a = 0; a < 2; ++a)
#pragma unroll
            for (int b = 0; b < 2; ++b)
#pragma unroll
                for (int m = 0; m < 4; ++m)
#pragma unroll
                    for (int n = 0; n < 2; ++n) acc[a][b][m][n] = (f32x4){0.f, 0.f, 0.f, 0.f};
        cur = nxt; cA = nA; cB = nB; ++ui;
        if constexpr (ALIGN_EPI) { if (wr == 1) PG8_BAR; }
    }
    PG8_WAIT_V(0);
    if constexpr (!ALIGN_EPI) { if (wr == 0) PG8_BAR; }
    PG8_BAR;
    if constexpr (Epi::AFTER_DRAIN) { E.fused(acc, cur, wr, wc, fr, fq, lds, wid, lane); S.done(cur); }
#undef PG8_SA
#undef PG8_SB
#undef PG8_STAGE
#undef PG8_LDA
#undef PG8_LDB
#undef PG8_MMA
#undef PG8_WAIT_V
#undef PG8_WAIT_L
#undef PG8_BAR
#undef PG8_SCHED
}
}

namespace mk {
constexpr int NWAVES = 8, NT = 512;
constexpr int DM = 1024, MP = 16384, NS = 128, SEQ = 2048, NB = 8;
constexpr int NPROJ = 4096, INC = 4120, UPN = 5632, DFF = 2816, DMIX = 2048, CONVD = 2048;
constexpr int NH = 24;
constexpr int PZ = 0, PX = 1536, PV = 3584;
constexpr float EPS = 1e-6f;
constexpr size_t O_YP = 0, O_YS = 16777216, O_SSMP = 16908288, O_SSMS = 17694720, O_CONVP = 30277632, O_CONVS = 30326784,
                 O_POOLP = 31113216, O_POOLS = 31174656, O_FFNP = 32157696, O_FFNS = 32247808, O_END = 33689600;
constexpr size_t KiB = 1024, MiB = 1048576;
constexpr size_t WS_CTL = 0, CTL_BYTES = 64 * KiB;
constexpr size_t WS_WIN = 64 * KiB;
constexpr size_t WS_WOUT = WS_WIN + 8 * MiB;
constexpr size_t WS_WUP = WS_WOUT + 4 * MiB;
constexpr size_t WS_WDN = WS_WUP + 11 * MiB;
constexpr size_t WS_WDT = WS_WDN + 5632 * KiB;
constexpr size_t WS_PWT = WS_WDT + 64 * KiB;
constexpr size_t WS_A = WS_PWT + 128 * KiB;
constexpr size_t WS_B = WS_A + 32 * MiB;
constexpr size_t WS_Y = WS_B + 128 * MiB;
constexpr size_t WS_DT = WS_Y + 64 * MiB;
constexpr size_t WS_CDEC = WS_DT + 1536 * KiB;
constexpr size_t WS_X1S = WS_CDEC + 16 * KiB;
constexpr size_t WS_XN2S = WS_X1S + 512 * KiB;
constexpr size_t WS_XN1S = WS_XN2S + 256 * KiB;
constexpr size_t WS_FCW = WS_XN1S + 256 * KiB;
constexpr size_t WS_END = WS_FCW + 128 * KiB;
static_assert(WS_END <= 256 * MiB, "workspace map");
constexpr size_t WB_H = 0, WB_UT = 88 * MiB, WB_UH = 91 * MiB, WB_SSP = 94 * MiB, WB_SSP2 = 95 * MiB, WB_HS = 96 * MiB, WB_X2S = 97 * MiB;
constexpr size_t OS_PROJS = O_FFNS, OS_DTS = O_FFNS + 128 * 4096, OS_YS = OS_DTS + 128 * 32;
static_assert(OS_YS + 131072 <= O_END, "sample scratch");
constexpr int LDS_BYTES = 163840, RING_OFF = 0, EX_OFF = 131072, MISC_OFF = LDS_BYTES - 512;
constexpr int CW_BAR = 4096;

#define LAS __attribute__((address_space(3)))
typedef unsigned short bf16;
typedef unsigned v4u __attribute__((ext_vector_type(4)));
typedef unsigned v2u __attribute__((ext_vector_type(2)));
typedef float f32x4 __attribute__((ext_vector_type(4)));
typedef short bf16x8 __attribute__((ext_vector_type(8)));
typedef short s16x4 __attribute__((ext_vector_type(4)));
#define LDS_WAIT() asm volatile("s_waitcnt lgkmcnt(0)" ::: "memory")
#define VM_WAIT() asm volatile("s_waitcnt vmcnt(0)" ::: "memory")
using pg8::cvt_pk_bf16; using pg8::silu_f;
__device__ __forceinline__ float bf2f(short h) { return __uint_as_float(((unsigned)(unsigned short)h) << 16); }
__device__ __forceinline__ unsigned short f2bf(float f) { return (unsigned short)(cvt_pk_bf16(f, 0.f) & 0xffffu); }
__device__ __forceinline__ float softplus_f(float x) { return x > 20.f ? x : log1pf(__expf(x)); }
__device__ __forceinline__ float wave_sum(float v) {
#pragma unroll
    for (int o = 1; o < 64; o <<= 1) v += __shfl_xor(v, o);
    return v;
}
__device__ __forceinline__ bf16x8 cat8(s16x4 lo, s16x4 hi) { bf16x8 r; r[0] = lo[0]; r[1] = lo[1]; r[2] = lo[2]; r[3] = lo[3]; r[4] = hi[0]; r[5] = hi[1]; r[6] = hi[2]; r[7] = hi[3]; return r; }
__device__ __forceinline__ s16x4 tr_read(const LAS bf16* p) { return __builtin_amdgcn_ds_read_tr16_b64_v4i16((LAS s16x4*)p); }
__device__ __forceinline__ int lane_now() { int t; asm volatile("v_mbcnt_lo_u32_b32 %0, -1, 0\n\tv_mbcnt_hi_u32_b32 %0, -1, %0" : "=v"(t)); return t; }
#define MFMA16(a, b, c) __builtin_amdgcn_mfma_f32_16x16x32_bf16((a), (b), (c), 0, 0, 0)
#define ARG(name, k) const float* const name = arg_in(k)
__device__ __forceinline__ const float* arg_in(int k) {
    typedef __attribute__((address_space(4))) const char* kptr_t; typedef __attribute__((address_space(1))) const float* gptr_t;
    kptr_t p = (kptr_t)__builtin_amdgcn_kernarg_segment_ptr(); asm volatile("" : "+s"(p));
    const unsigned long long raw = *(__attribute__((address_space(4))) const unsigned long long*)(p + 8 * k);
    return (const float*)(gptr_t)raw; }

#define XB_TMO      128
#define XB_XCNT(j)  (256  + 64 * (j))
#define XB_XSUB(j)  (1280 + 64 * (j))
#define XB_XGEN(j)  (2304 + 64 * (j))
#define XB_TOP      3328
#define XB_TOPGEN   3392
#define XCD_BAR_WORDS 3456
#define XB_SPIN_CAP (1u << 18)

__device__ __forceinline__ unsigned xb_ld(unsigned* p)              { return __hip_atomic_load(p, __ATOMIC_RELAXED, __HIP_MEMORY_SCOPE_AGENT); }
__device__ __forceinline__ unsigned xb_add(unsigned* p, unsigned v) { return __hip_atomic_fetch_add(p, v, __ATOMIC_RELAXED, __HIP_MEMORY_SCOPE_AGENT); }
__device__ __forceinline__ unsigned xb_xcc_id() { return (unsigned)__builtin_amdgcn_s_getreg((3 << 11) | 20) & 0xFu; }
#define XB_SPIN(cond, bar) do { unsigned _sp = 0; while (cond) { __builtin_amdgcn_s_sleep(1); \
    if ((++_sp & 255u) == 0u) { if (xb_ld(&(bar)[XB_TMO])) break; if (_sp > XB_SPIN_CAP) { atomicAdd(&(bar)[XB_TMO], 1u); break; } } } } while (0)

struct XcdBarrier {
    unsigned* bar; unsigned x;
    volatile LAS unsigned* st;
};

__device__ __forceinline__ XcdBarrier xcd_barrier_post(unsigned* bar, volatile LAS unsigned* st, const bool t0) {
    XcdBarrier b; b.bar = bar; b.x = xb_xcc_id(); b.st = st;
    if (t0) (void)xb_add(&bar[XB_XCNT(b.x)], 1u);
    return b;
}
__device__ __forceinline__ void xcd_barrier_complete(unsigned* bar, unsigned x, unsigned& nloc, unsigned& nx) {
    const unsigned G = gridDim.x * gridDim.y * gridDim.z;
    unsigned sum, cnt, mine, sp = 0u;
    for (;;) {
        sum = 0u; cnt = 0u; mine = 0u;
#pragma unroll
        for (unsigned j = 0; j < 16; ++j) { const unsigned c = xb_ld(&bar[XB_XCNT(j)]); sum += c; cnt += (c > 0u) ? 1u : 0u; mine = (j == x) ? c : mine; }
        if (sum == G) break;
        __builtin_amdgcn_s_sleep(1);
        if ((++sp & 255u) == 0u) { if (xb_ld(&bar[XB_TMO])) break; if (sp > XB_SPIN_CAP) { atomicAdd(&bar[XB_TMO], 1u); break; } }
    }
    nloc = mine > 0u ? mine : 1u; nx = cnt > 0u ? cnt : 1u;
}

__device__ __forceinline__ void xcd_barrier(const XcdBarrier& b, const bool t0) {
    asm volatile("s_waitcnt vmcnt(0)" ::: "memory");
    __syncthreads();
    if (t0) {
        unsigned* bar = b.bar;
        __builtin_amdgcn_s_waitcnt(0);
        unsigned nloc = b.st[0], nx = b.st[1];
        if (nloc == 0u) { xcd_barrier_complete(bar, b.x, nloc, nx); b.st[0] = nloc; b.st[1] = nx; }
        const unsigned old = xb_add(&bar[XB_XSUB(b.x)], 1u);
        const unsigned gen = old / nloc;
        if (old + 1u == (gen + 1u) * nloc) {
            __builtin_amdgcn_fence(__ATOMIC_RELEASE, "agent");
            asm volatile("s_waitcnt vmcnt(0)" ::: "memory");
            const unsigned og = xb_add(&bar[XB_TOP], 1u);
            const unsigned tg = og / nx;
            if (og + 1u == (tg + 1u) * nx) xb_add(&bar[XB_TOPGEN], 1u);
            else XB_SPIN(xb_ld(&bar[XB_TOPGEN]) == tg, bar);
            __builtin_amdgcn_fence(__ATOMIC_ACQUIRE, "agent");
            xb_add(&bar[XB_XGEN(b.x)], 1u);
            asm volatile("s_waitcnt vmcnt(0)" ::: "memory");
        } else {
            XB_SPIN(xb_ld(&bar[XB_XGEN(b.x)]) == gen, bar);
            __builtin_amdgcn_fence(__ATOMIC_ACQUIRE, "agent");
            asm volatile("s_waitcnt vmcnt(0)" ::: "memory");
        }
    }
    __syncthreads();
}

struct Ctx { LAS unsigned char* lds; int tid, lane, wave, vcu, G; };

__device__ __forceinline__ void transpose_item(const float* W, int ldw, int k0, int ns0, int nvalid, int nout, bf16* WT, int K, int drow0, const float* fold, LAS float* scr, int lane) {
    const int c4 = lane & 15, r = lane >> 4;
    f32x4 v[16];
#pragma unroll
    for (int i = 0; i < 16; ++i) v[i] = (4 * c4 < nvalid) ? *(const f32x4*)(W + (size_t)(k0 + 4 * i + r) * ldw + ns0 + 4 * c4) : (f32x4){0.f, 0.f, 0.f, 0.f};
    if (fold) {
#pragma unroll
        for (int i = 0; i < 16; ++i) v[i] = v[i] * fold[k0 + 4 * i + r]; }
#pragma unroll
    for (int i = 0; i < 16; ++i) { LAS float* d = scr + (4 * i + r) * 65 + 4 * c4; d[0] = v[i][0]; d[1] = v[i][1]; d[2] = v[i][2]; d[3] = v[i][3]; }
    LDS_WAIT(); asm volatile("" ::: "memory");
    const int c = lane & 7;
#pragma unroll
    for (int j = 0; j < 8; ++j) { const int n = (lane >> 3) + 8 * j; const LAS float* q = scr + (8 * c) * 65 + n;
        v4u o; o.x = cvt_pk_bf16(q[0 * 65], q[1 * 65]); o.y = cvt_pk_bf16(q[2 * 65], q[3 * 65]); o.z = cvt_pk_bf16(q[4 * 65], q[5 * 65]); o.w = cvt_pk_bf16(q[6 * 65], q[7 * 65]);
        if (n < nout) *(v4u*)(WT + (size_t)(drow0 + n) * K + k0 + 8 * c) = o; }
    LDS_WAIT(); asm volatile("" ::: "memory");
}
template <int NR> __device__ __forceinline__ void rms_rows_to_bf16(const float* xrow, const float* w, bf16* orow, int lane) {
    f32x4 v[NR][4];
#pragma unroll
    for (int q = 0; q < NR; ++q)
#pragma unroll
        for (int j = 0; j < 4; ++j) v[q][j] = ((const f32x4*)(xrow + (size_t)q * 1024))[lane + 64 * j];
    f32x4 ww[4];
#pragma unroll
    for (int j = 0; j < 4; ++j) ww[j] = w ? ((const f32x4*)w)[lane + 64 * j] : (f32x4){1.f, 1.f, 1.f, 1.f};
#pragma unroll
    for (int q = 0; q < NR; ++q) { float s = 0.f;
#pragma unroll
        for (int j = 0; j < 4; ++j) s += (v[q][j][0] * v[q][j][0] + v[q][j][1] * v[q][j][1]) + (v[q][j][2] * v[q][j][2] + v[q][j][3] * v[q][j][3]);
        const float rs = __builtin_amdgcn_rsqf(wave_sum(s) * (1.0f / 1024.0f) + EPS);
        v2u* o8 = (v2u*)(orow + (size_t)q * 1024) + lane;
#pragma unroll
        for (int j = 0; j < 4; ++j) { v2u o; o.x = cvt_pk_bf16(v[q][j][0] * rs * ww[j][0], v[q][j][1] * rs * ww[j][1]); o.y = cvt_pk_bf16(v[q][j][2] * rs * ww[j][2], v[q][j][3] * rs * ww[j][3]); o8[64 * j] = o; } }
}
__device__ __forceinline__ void rms_row_to_bf16(const float* xrow, const float* w, bf16* orow, int lane) { rms_rows_to_bf16<1>(xrow, w, orow, lane); }

template <int R16, int K> __device__ __forceinline__ void skinny_acc(const bf16* A, const bf16* Wt, int row0, int n0, int wave, int lane, f32x4 (&acc)[R16]) {
    constexpr int KW = K / 8, NS_ = KW / 32;
    static_assert(KW % 32 == 0, "K split");
    const bf16* ap = A + (size_t)(row0 + (lane & 15)) * K + wave * KW + 8 * (lane >> 4);
    const bf16* bp = Wt + (size_t)(n0 + (lane & 15)) * K + wave * KW + 8 * (lane >> 4);
#pragma unroll
    for (int mi = 0; mi < R16; ++mi) acc[mi] = (f32x4){0.f, 0.f, 0.f, 0.f};
#pragma unroll
    for (int ks = 0; ks < NS_; ++ks) { const bf16x8 b = *(const bf16x8*)(bp + 32 * ks);
#pragma unroll
        for (int mi = 0; mi < R16; ++mi) { const bf16x8 a = *(const bf16x8*)(ap + (size_t)mi * 16 * K + 32 * ks); acc[mi] = MFMA16(a, b, acc[mi]); } }
}
template <int R16> __device__ __forceinline__ f32x4 skinny_reduce(LAS float* red, const f32x4 (&acc)[R16], int wave, int lane, int tid) {
#pragma unroll
    for (int mi = 0; mi < R16; ++mi) *(LAS f32x4*)(red + ((wave * R16 + mi) * 64 + lane) * 4) = acc[mi];
    __syncthreads();
    f32x4 s = (f32x4){0.f, 0.f, 0.f, 0.f};
    if ((tid >> 6) < R16) {
#pragma unroll
        for (int w = 0; w < 8; ++w) s += *(const LAS f32x4*)(red + ((w * R16 + (tid >> 6)) * 64 + (tid & 63)) * 4);
    }
    __syncthreads();
    return s;
}

constexpr int XS = 392, BS = 72;
constexpr int S_XS = 0, S_BS = 128 * XS * 2, S_CS = S_BS + 128 * BS * 2, S_AC = S_CS + 128 * BS * 2, S_DT = S_AC + 6 * 128 * 4, S_WV = S_DT + 6 * 128 * 4, S_END = S_WV + 6 * 128 * 4;
static_assert(S_END <= MISC_OFF, "S-phase LDS map");
template <bool WITH_C> __device__ __forceinline__ void conv_stage(const Ctx& F, const bf16* PROJ, int b, int c, int g, float* conv_out) {
    ARG(conv_w, 8);
    ARG(conv_b, 9);
    const int cg = F.tid & 63, rs = F.tid >> 6;
    int ch; LAS bf16* dst; int dstride;
    if (cg < 48) { ch = 384 * g + 8 * cg; dst = (LAS bf16*)(F.lds + S_XS) + 8 * cg; dstride = XS; }
    else if (cg < 56) { ch = 1536 + 64 * g + 8 * (cg - 48); dst = (LAS bf16*)(F.lds + S_BS) + 8 * (cg - 48); dstride = BS; }
    else { ch = 1792 + 64 * g + 8 * (cg - 56); dst = (LAS bf16*)(F.lds + S_CS) + 8 * (cg - 56); dstride = BS; }
    if (!WITH_C && cg >= 56) return;
    float w[4][8], bias[8];
#pragma unroll
    for (int k = 0; k < 4; ++k) { const f32x4 a = *(const f32x4*)(conv_w + k * CONVD + ch), d = *(const f32x4*)(conv_w + k * CONVD + ch + 4);
        w[k][0] = a[0]; w[k][1] = a[1]; w[k][2] = a[2]; w[k][3] = a[3]; w[k][4] = d[0]; w[k][5] = d[1]; w[k][6] = d[2]; w[k][7] = d[3]; }
    { const f32x4 a = *(const f32x4*)(conv_b + ch), d = *(const f32x4*)(conv_b + ch + 4);
        bias[0] = a[0]; bias[1] = a[1]; bias[2] = a[2]; bias[3] = a[3]; bias[4] = d[0]; bias[5] = d[1]; bias[6] = d[2]; bias[7] = d[3]; }
    const bf16* src = PROJ + ((size_t)b * SEQ + c * 128 + 16 * rs) * NPROJ + PX + ch;
    float r0[8], r1[8], r2[8];
    const bool zero_hist = (c == 0 && rs == 0);
    { bf16x8 h0 = {0,0,0,0,0,0,0,0}, h1 = h0, h2 = h0;
      if (!zero_hist) { h0 = *(const bf16x8*)(src - 3 * NPROJ); h1 = *(const bf16x8*)(src - 2 * NPROJ); h2 = *(const bf16x8*)(src - 1 * NPROJ); }
#pragma unroll
      for (int j = 0; j < 8; ++j) { r0[j] = bf2f(h0[j]); r1[j] = bf2f(h1[j]); r2[j] = bf2f(h2[j]); } }
#pragma unroll 4
    for (int i = 0; i < 16; ++i) { const int l = 16 * rs + i;
        const bf16x8 raw = *(const bf16x8*)(src + (size_t)i * NPROJ);
        float cur[8], o[8];
#pragma unroll
        for (int j = 0; j < 8; ++j) { cur[j] = bf2f(raw[j]); o[j] = silu_f(bias[j] + w[0][j] * r0[j] + w[1][j] * r1[j] + w[2][j] * r2[j] + w[3][j] * cur[j]); }
        v4u pk; pk.x = cvt_pk_bf16(o[0], o[1]); pk.y = cvt_pk_bf16(o[2], o[3]); pk.z = cvt_pk_bf16(o[4], o[5]); pk.w = cvt_pk_bf16(o[6], o[7]);
        *(LAS v4u*)(dst + l * dstride) = pk;
        if (conv_out && l >= 125) { float* op = conv_out + (size_t)(l - 125) * CONVD + ch;
            *(f32x4*)op = (f32x4){cur[0], cur[1], cur[2], cur[3]}; *(f32x4*)(op + 4) = (f32x4){cur[4], cur[5], cur[6], cur[7]}; }
#pragma unroll
        for (int j = 0; j < 8; ++j) { r0[j] = r1[j]; r1[j] = r2[j]; r2[j] = cur[j]; } }
}
__device__ __forceinline__ void dt_stage(const Ctx& F, const float* DT, int b, int c, int g, float* cdec_out) {
    ARG(a_log, 11);
    if (F.wave < 6) { const int hh = 6 * g + F.wave; const float a = -__expf(a_log[hh]);
        const size_t row = (size_t)b * SEQ + c * 128 + 2 * F.lane;
        const float d0 = DT[row * 24 + hh], d1 = DT[(row + 1) * 24 + hh];
        const float v0 = d0 * a, v1 = d1 * a; float s = v0 + v1;
#pragma unroll
        for (int o = 1; o < 64; o <<= 1) { const float t = __shfl_up(s, o); if (F.lane >= o) s += t; }
        const float tot = __shfl(s, 63);
        LAS float* ac = (LAS float*)(F.lds + S_AC) + F.wave * 128 + 2 * F.lane;
        LAS float* dl = (LAS float*)(F.lds + S_DT) + F.wave * 128 + 2 * F.lane;
        LAS float* wv = (LAS float*)(F.lds + S_WV) + F.wave * 128 + 2 * F.lane;
        const float a0 = s - v1, a1 = s;
        ac[0] = a0; ac[1] = a1; dl[0] = d0; dl[1] = d1; wv[0] = __expf(tot - a0) * d0; wv[1] = __expf(tot - a1) * d1;
        if (cdec_out && F.lane == 0) cdec_out[hh] = __expf(tot); }
}

__device__ __forceinline__ void s1_unit(const Ctx& F, const bf16* PROJ, const float* DT, float* CS, float* CDEC, float* conv_prompt, int unit) {
    const int g = unit & 3, c = (unit >> 2) & 15, b = unit >> 6;
    conv_stage<true>(F, PROJ, b, c, g, (c == 15) ? conv_prompt + (size_t)b * 3 * CONVD : nullptr);
    dt_stage(F, DT, b, c, g, CDEC + (b * 16 + c) * 24);
    __syncthreads();
    const int i = F.lane & 15, g4 = F.lane >> 4;
    const LAS bf16* xs = (const LAS bf16*)(F.lds + S_XS); const LAS bf16* Bs = (const LAS bf16*)(F.lds + S_BS); const LAS float* wv = (const LAS float*)(F.lds + S_WV);
    bf16x8 Bf[4][4];
#pragma unroll
    for (int nt = 0; nt < 4; ++nt)
#pragma unroll
        for (int ks = 0; ks < 4; ++ks) { const LAS bf16* p = Bs + (32 * ks + 4 * g4 + (i >> 2)) * BS + 16 * nt + 4 * (i & 3); Bf[nt][ks] = cat8(tr_read(p), tr_read(p + 16 * BS)); }
#pragma unroll 1
    for (int pr = 0; pr < 3; ++pr) { const int pair = F.wave * 3 + pr, h = pair >> 2, pt = pair & 3;
        bf16x8 Af[4];
#pragma unroll
        for (int ks = 0; ks < 4; ++ks) { const LAS bf16* p = xs + (32 * ks + 4 * g4 + (i >> 2)) * XS + 64 * h + 16 * pt + 4 * (i & 3);
            const s16x4 lo = tr_read(p), hi = tr_read(p + 16 * XS);
            const f32x4 w0 = *(const LAS f32x4*)(wv + h * 128 + 32 * ks + 4 * g4), w1 = *(const LAS f32x4*)(wv + h * 128 + 32 * ks + 16 + 4 * g4);
            v4u pk; pk.x = cvt_pk_bf16(bf2f(lo[0]) * w0[0], bf2f(lo[1]) * w0[1]); pk.y = cvt_pk_bf16(bf2f(lo[2]) * w0[2], bf2f(lo[3]) * w0[3]);
            pk.z = cvt_pk_bf16(bf2f(hi[0]) * w1[0], bf2f(hi[1]) * w1[1]); pk.w = cvt_pk_bf16(bf2f(hi[2]) * w1[2], bf2f(hi[3]) * w1[3]);
            Af[ks] = __builtin_bit_cast(bf16x8, pk); }
        f32x4 acc[4];
#pragma unroll
        for (int nt = 0; nt < 4; ++nt) { acc[nt] = (f32x4){0.f, 0.f, 0.f, 0.f};
#pragma unroll
            for (int ks = 0; ks < 4; ++ks) acc[nt] = MFMA16(Bf[nt][ks], Af[ks], acc[nt]); }
        float* o = CS + ((((size_t)b * 16 + c) * 24 + 6 * g + h) * 64 + 16 * pt + i) * 64 + 4 * g4;
#pragma unroll
        for (int nt = 0; nt < 4; ++nt) *(f32x4*)(o + 16 * nt) = acc[nt]; }
    __syncthreads();
}

constexpr int VS = 136;
constexpr int PL_V = 0, PL_M = 143 * VS * 2;
__device__ __forceinline__ void pool_unit(const Ctx& F, const bf16* PROJ, const bf16* PWt, bf16* Y, float* pool_prompt, int unit) {
    ARG(pool_scale, 15);
    const int g = unit & 3, tt = unit >> 2, b = tt >> 4, t0 = (tt & 15) * 128;
    LAS bf16* vs = (LAS bf16*)(F.lds + PL_V); LAS bf16* ms = (LAS bf16*)(F.lds + PL_M);
    for (int it = F.tid; it < 143 * 16; it += NT) { const int r = it >> 4, cgp = it & 15; const int t = t0 - 15 + r;
        v4u v = (v4u){0u, 0u, 0u, 0u};
        if (t >= 0) v = *(const v4u*)(PROJ + ((size_t)b * SEQ + t) * NPROJ + PV + 128 * g + 8 * cgp);
        *(LAS v4u*)(vs + r * VS + 8 * cgp) = v; }
    __syncthreads();
    const int w = 2 << g;
    for (int it = F.tid; it < 128 * 16; it += NT) { const int l = it >> 4, cgp = it & 15;
        float s[8] = {0.f, 0.f, 0.f, 0.f, 0.f, 0.f, 0.f, 0.f}; bf16x8 cur;
        for (int j = 0; j < w; ++j) { cur = *(const LAS bf16x8*)(vs + (l + 15 - (w - 1) + j) * VS + 8 * cgp);
#pragma unroll
            for (int e = 0; e < 8; ++e) s[e] += bf2f(cur[e]); }
        const int cnt = (t0 + l + 1 < w) ? (t0 + l + 1) : w; const float inv = 1.0f / (float)cnt;
        float o[8];
#pragma unroll
        for (int e = 0; e < 8; ++e) o[e] = s[e] * inv - bf2f(cur[e]);
        v4u pk; pk.x = cvt_pk_bf16(o[0], o[1]); pk.y = cvt_pk_bf16(o[2], o[3]); pk.z = cvt_pk_bf16(o[4], o[5]); pk.w = cvt_pk_bf16(o[6], o[7]);
        *(LAS v4u*)(ms + l * VS + 8 * cgp) = pk; }
    if ((tt & 15) == 15) {
        for (int it = F.tid; it < 15 * 128; it += NT) { const int r = it >> 7, cc = it & 127;
            pool_prompt[((size_t)b * 15 + r) * 512 + 128 * g + cc] = bf2f((short)vs[(128 + r) * VS + cc]); } }
    __syncthreads();
    const int i = F.lane & 15, g4 = F.lane >> 4;
    bf16x8 Af[4];
#pragma unroll
    for (int ks = 0; ks < 4; ++ks) Af[ks] = *(const LAS bf16x8*)(ms + (16 * F.wave + i) * VS + 32 * ks + 8 * g4);
    const size_t row = (size_t)b * SEQ + t0 + 16 * F.wave + i;
#pragma unroll
    for (int nt = 0; nt < 8; ++nt) { f32x4 acc = (f32x4){0.f, 0.f, 0.f, 0.f};
#pragma unroll
        for (int ks = 0; ks < 4; ++ks) { const bf16x8 bfr = *(const bf16x8*)(PWt + ((size_t)g * 128 + 16 * nt + i) * 128 + 32 * ks + 8 * g4); acc = MFMA16(bfr, Af[ks], acc); }
        const f32x4 sc = *(const f32x4*)(pool_scale + 128 * g + 16 * nt + 4 * g4);
        v2u pk; pk.x = cvt_pk_bf16(acc[0] * sc[0], acc[1] * sc[1]); pk.y = cvt_pk_bf16(acc[2] * sc[2], acc[3] * sc[3]);
        *(v2u*)(Y + row * DMIX + 1536 + 128 * g + 16 * nt + 4 * g4) = pk; }
    __syncthreads();
}

__device__ __forceinline__ void ssm_sample_unit(const Ctx& F, float* out, int unit) {
    ARG(state_ssm, 2);
    ARG(state_conv, 3);
    ARG(conv_w, 8);
    ARG(conv_b, 9);
    ARG(a_log, 11);
    ARG(d_skip, 12);
    ARG(ssd_norm_w, 13);
    const float* PROJS = out + OS_PROJS; const float* DTS = out + OS_DTS; bf16* YS = (bf16*)(out + OS_YS); float* ssm_out = out + O_SSMS; float* conv_out = out + O_CONVS;
    const int g = unit & 3, b = unit >> 2, tid = F.tid;
    LAS float* sx = (LAS float*)F.lds;
    LAS float* sy = sx + 512;
    LAS float* sred = sy + 384;
    const int p = tid >> 3, ng = tid & 7;
    f32x4 h0[6][2];
#pragma unroll
    for (int h = 0; h < 6; ++h) { const float* sp = state_ssm + ((((size_t)b * NH + 6 * g + h) * 64 + p) * 64 + 8 * ng); h0[h][0] = *(const f32x4*)sp; h0[h][1] = *(const f32x4*)(sp + 4); }
    { const int ch = (tid < 384) ? 384 * g + tid : (tid < 448 ? 1536 + 64 * g + (tid - 384) : 1792 + 64 * g + (tid - 448));
      const float* st = state_conv + (size_t)b * 3 * CONVD + ch; const float s0 = st[0], s1 = st[CONVD], s2 = st[2 * CONVD], nw = PROJS[(size_t)b * NPROJ + PX + ch];
      sx[tid] = silu_f(conv_b[ch] + conv_w[ch] * s0 + conv_w[CONVD + ch] * s1 + conv_w[2 * CONVD + ch] * s2 + conv_w[3 * CONVD + ch] * nw);
      float* co = conv_out + (size_t)b * 3 * CONVD + ch; co[0] = s1; co[CONVD] = s2; co[2 * CONVD] = nw; }
    __syncthreads();
    float bn[8], cn[8];
#pragma unroll
    for (int j = 0; j < 8; ++j) { bn[j] = sx[384 + 8 * ng + j]; cn[j] = sx[448 + 8 * ng + j]; }
    float ssq = 0.f;
#pragma unroll
    for (int h = 0; h < 6; ++h) { const int hh = 6 * g + h; const float dt = DTS[b * 24 + hh], dA = __expf(-dt * __expf(a_log[hh])); const float xp = sx[64 * h + p], dx = dt * xp;
        f32x4 n0, n1; float yp = 0.f;
#pragma unroll
        for (int j = 0; j < 4; ++j) { n0[j] = dA * h0[h][0][j] + dx * bn[j]; n1[j] = dA * h0[h][1][j] + dx * bn[4 + j]; yp += cn[j] * n0[j] + cn[4 + j] * n1[j]; }
        float* op = ssm_out + ((((size_t)b * NH + hh) * 64 + p) * 64 + 8 * ng); *(f32x4*)op = n0; *(f32x4*)(op + 4) = n1;
        yp += __shfl_xor(yp, 1); yp += __shfl_xor(yp, 2); yp += __shfl_xor(yp, 4);
        const float y = (yp + d_skip[hh] * xp) * silu_f(PROJS[(size_t)b * NPROJ + PZ + 64 * hh + p]);
        if (ng == 0) { sy[64 * h + p] = y; ssq += y * y; } }
    ssq = wave_sum(ssq);
    if (F.lane == 0) sred[F.wave] = ssq;
    __syncthreads();
    float tot = 0.f;
#pragma unroll
    for (int w = 0; w < 8; ++w) tot += sred[w];
    const float rs = 1.0f / sqrtf(tot * (1.0f / 384.0f) + EPS);
    if (tid < 384) YS[(size_t)b * DMIX + 384 * g + tid] = f2bf(sy[tid] * rs * ssd_norm_w[384 * g + tid]);
    __syncthreads();
}
__device__ __forceinline__ void pool_sample_unit(const Ctx& F, float* out, int b) {
    ARG(state_pool, 4);
    ARG(pool_w, 14);
    ARG(pool_scale, 15);
    const float* PROJS = out + OS_PROJS; bf16* YS = (bf16*)(out + OS_YS); float* pool_out = out + O_POOLS;
    LAS float* sm = (LAS float*)F.lds; const int tid = F.tid, g = F.wave >> 1, w = 2 << g;
    const float vn = PROJS[(size_t)b * NPROJ + PV + tid]; const float* sp = state_pool + (size_t)b * 15 * 512 + tid; float* po = pool_out + (size_t)b * 15 * 512 + tid;
    float s = vn;
#pragma unroll
    for (int r = 0; r < 15; ++r) { const float v = sp[r * 512]; if (r >= 15 - (w - 1)) s += v; if (r >= 1) po[(r - 1) * 512] = v; }
    po[14 * 512] = vn;
    sm[tid] = s * (1.0f / (float)w) - vn;
    __syncthreads();
    const int d = tid & 127; const float* pw = pool_w + (size_t)g * 16384 + d; float acc = 0.f;
#pragma unroll 8
    for (int c = 0; c < 128; ++c) acc += sm[128 * g + c] * pw[c * 128];
    YS[(size_t)b * DMIX + 1536 + tid] = f2bf(acc * pool_scale[tid]);
    __syncthreads();
}

__device__ __forceinline__ void s3_unit(const Ctx& F, const bf16* PROJ, const float* DT, const bf16* HIN, bf16* Y, int unit) {
    ARG(d_skip, 12);
    ARG(ssd_norm_w, 13);
    const int g = unit & 3, c = (unit >> 2) & 15, b = unit >> 6;
    conv_stage<true>(F, PROJ, b, c, g, nullptr);
    dt_stage(F, DT, b, c, g, nullptr);
    __syncthreads();
    const int i = F.lane & 15, g4 = F.lane >> 4, w = F.wave, lrow = 16 * w + i;
    const LAS bf16* xs = (const LAS bf16*)(F.lds + S_XS); const LAS bf16* Bs = (const LAS bf16*)(F.lds + S_BS); const LAS bf16* Cs = (const LAS bf16*)(F.lds + S_CS);
    const LAS float* acs = (const LAS float*)(F.lds + S_AC); const LAS float* dts = (const LAS float*)(F.lds + S_DT);
    bf16x8 Cf[2];
#pragma unroll
    for (int ks = 0; ks < 2; ++ks) Cf[ks] = *(const LAS bf16x8*)(Cs + lrow * BS + 32 * ks + 8 * g4);
    f32x4 X[8];
#pragma unroll
    for (int st = 0; st < 8; ++st) { X[st] = (f32x4){0.f, 0.f, 0.f, 0.f};
        if (st <= w) {
#pragma unroll
            for (int ks = 0; ks < 2; ++ks) { const bf16x8 a = *(const LAS bf16x8*)(Bs + (16 * st + i) * BS + 32 * ks + 8 * g4); X[st] = MFMA16(a, Cf[ks], X[st]); } } }
    const size_t grow = (size_t)b * SEQ + c * 128 + lrow;
    float mk[4], dg[4];
#pragma unroll
    for (int r = 0; r < 4; ++r) { mk[r] = (4 * g4 + r <= i) ? 1.f : 0.f; dg[r] = (4 * g4 + r == i) ? 1.f : 0.f; }
    float ssq = 0.f;
#pragma unroll 1
    for (int h = 0; h < 6; ++h) { const int hh = 6 * g + h; const float al = acs[h * 128 + lrow], Dh = d_skip[hh];
        f32x4 ya[4], yo[4];
#pragma unroll
        for (int pt = 0; pt < 4; ++pt) { ya[pt] = (f32x4){0.f, 0.f, 0.f, 0.f}; yo[pt] = (f32x4){0.f, 0.f, 0.f, 0.f}; }
#pragma unroll
        for (int u = 0; u < 4; ++u) { if (2 * u <= w) {
            float mv[8];
#pragma unroll
            for (int hf = 0; hf < 2; ++hf) { const int st = 2 * u + hf;
                if (st < w) { const f32x4 as4 = *(const LAS f32x4*)(acs + h * 128 + 16 * st + 4 * g4), dt4 = *(const LAS f32x4*)(dts + h * 128 + 16 * st + 4 * g4);
#pragma unroll
                    for (int r = 0; r < 4; ++r) mv[4 * hf + r] = X[st][r] * __expf(al - as4[r]) * dt4[r]; }
                else if (st == w) { const f32x4 as4 = *(const LAS f32x4*)(acs + h * 128 + 16 * st + 4 * g4), dt4 = *(const LAS f32x4*)(dts + h * 128 + 16 * st + 4 * g4);
#pragma unroll
                    for (int r = 0; r < 4; ++r) mv[4 * hf + r] = X[st][r] * __expf(fminf(al - as4[r], 0.f)) * dt4[r] * mk[r] + Dh * dg[r]; }
                else {
#pragma unroll
                    for (int r = 0; r < 4; ++r) mv[4 * hf + r] = 0.f; } }
            v4u pk; pk.x = cvt_pk_bf16(mv[0], mv[1]); pk.y = cvt_pk_bf16(mv[2], mv[3]); pk.z = cvt_pk_bf16(mv[4], mv[5]); pk.w = cvt_pk_bf16(mv[6], mv[7]);
            const bf16x8 mf = __builtin_bit_cast(bf16x8, pk);
#pragma unroll
            for (int pt = 0; pt < 4; ++pt) { const LAS bf16* p = xs + (32 * u + 4 * g4 + (i >> 2)) * XS + 64 * h + 16 * pt + 4 * (i & 3);
                const bf16x8 xf = cat8(tr_read(p), tr_read(p + 16 * XS)); ya[pt] = MFMA16(xf, mf, ya[pt]); } } }
        const bf16* hp = HIN + (((size_t)b * 16 + c) * 24 + hh) * 4096;
#pragma unroll
        for (int pt = 0; pt < 4; ++pt)
#pragma unroll
            for (int ks = 0; ks < 2; ++ks) { const bf16x8 hf = *(const bf16x8*)(hp + (16 * pt + i) * 64 + 32 * ks + 8 * g4); yo[pt] = MFMA16(hf, Cf[ks], yo[pt]); }
        const float el = __expf(al);
#pragma unroll
        for (int pt = 0; pt < 4; ++pt) { const s16x4 z4 = *(const s16x4*)(PROJ + grow * NPROJ + PZ + 64 * hh + 16 * pt + 4 * g4);
            float yy[4];
#pragma unroll
            for (int r = 0; r < 4; ++r) { const float y = (ya[pt][r] + el * yo[pt][r]) * silu_f(bf2f(z4[r])); yy[r] = y; ssq += y * y; }
            v2u pk; pk.x = cvt_pk_bf16(yy[0], yy[1]); pk.y = cvt_pk_bf16(yy[2], yy[3]);
            *(v2u*)(Y + grow * DMIX + 64 * hh + 16 * pt + 4 * g4) = pk; } }
    ssq += __shfl_xor(ssq, 16); ssq += __shfl_xor(ssq, 32);
    const float rs = 1.0f / sqrtf(ssq * (1.0f / 384.0f) + EPS);
    VM_WAIT();
#pragma unroll 2
    for (int hp2 = 0; hp2 < 24; ++hp2) { const int col = 384 * g + 16 * hp2 + 4 * g4; const f32x4 nw = *(const f32x4*)(ssd_norm_w + col);
        const v2u yb = *(const v2u*)(Y + grow * DMIX + col);
        v2u pk; pk.x = cvt_pk_bf16(__uint_as_float(yb.x << 16) * rs * nw[0], __uint_as_float(yb.x & 0xffff0000u) * rs * nw[1]); pk.y = cvt_pk_bf16(__uint_as_float(yb.y << 16) * rs * nw[2], __uint_as_float(yb.y & 0xffff0000u) * rs * nw[3]);
        *(v2u*)(Y + grow * DMIX + col) = pk; }
    __syncthreads();
}

struct Args { const float* in[23]; float* out; unsigned char* ws; int ph_lo, ph_hi; };
constexpr int NPHASE = 9;
#define MK_EN(k) (((MASK) >> (k)) & 1)
#ifndef MK_P2DUP
#define MK_P2DUP 0
#endif
#ifndef MK_P6DUP
#define MK_P6DUP 0
#endif
#ifndef MK_P7DUP
#define MK_P7DUP 0
#endif
#ifndef MK_P8DUP
#define MK_P8DUP 0
#endif
#ifndef MK_DUP
#define MK_DUP 0
#endif
#define MK_DUPK(k) (((MK_DUP) >> (k)) & 1)

template <int MASK> __global__ void __launch_bounds__(NT, 2) mk_fwd(Args args) {
    extern __shared__ __attribute__((aligned(16))) unsigned char lds_raw[];
    Ctx F;
    F.lds = (LAS unsigned char*)lds_raw;
    F.wave = __builtin_amdgcn_readfirstlane(threadIdx.x >> 6);
#define REFRESH() do { F.lane = lane_now(); F.tid = F.wave * 64 + F.lane; } while (0)
    REFRESH();
    F.G = gridDim.x; { const int bx = blockIdx.x; F.vcu = (F.G % 8 == 0) ? (bx % 8) * (F.G / 8) + bx / 8 : bx; }
    volatile LAS unsigned* MISC = (volatile LAS unsigned*)(F.lds + MISC_OFF);
    if (F.tid < 128) MISC[F.tid] = 0u;
    __syncthreads();
    unsigned char* ws = args.ws; float* out = args.out;
    unsigned* ctl = (unsigned*)(ws + WS_CTL);
    const int lo = args.ph_lo, hi = args.ph_hi;
    XcdBarrier bar; bar.bar = ctl + CW_BAR; bar.x = 0; bar.st = nullptr;
    if (hi - lo > 1) bar = xcd_barrier_post(ctl + CW_BAR, MISC + 8, F.tid == 0);
#define IN(k) (lo <= (k) && (k) < hi)
#define SEAM(k) do { REFRESH(); if (IN(k) && IN((k) + 1)) xcd_barrier(bar, F.tid == 0); REFRESH(); } while (0)
    bf16* Win_t = (bf16*)(ws + WS_WIN); bf16* Wout_t = (bf16*)(ws + WS_WOUT); bf16* Wup_t = (bf16*)(ws + WS_WUP); bf16* Wdn_t = (bf16*)(ws + WS_WDN);
    bf16* Wdt_t = (bf16*)(ws + WS_WDT); bf16* PWt = (bf16*)(ws + WS_PWT);
    bf16* XN1 = (bf16*)(ws + WS_A); bf16* HIN = (bf16*)(ws + WS_A); bf16* X1b = (bf16*)(ws + WS_A);
    bf16* PROJ = (bf16*)(ws + WS_B); bf16* Hb = (bf16*)(ws + WS_B + WB_H); float* UT = (float*)(ws + WS_B + WB_UT); float* UH = (float*)(ws + WS_B + WB_UH);
    float* SSP = (float*)(ws + WS_B + WB_SSP); float* SSP2 = (float*)(ws + WS_B + WB_SSP2); bf16* HS = (bf16*)(ws + WS_B + WB_HS); float* X2S = (float*)(ws + WS_B + WB_X2S);
    bf16* Y = (bf16*)(ws + WS_Y); float* DT = (float*)(ws + WS_DT); float* CDEC = (float*)(ws + WS_CDEC);
    float* X1S = (float*)(ws + WS_X1S); bf16* XN2S = (bf16*)(ws + WS_XN2S); bf16* XN1S = (bf16*)(ws + WS_XN1S);
    float* PROJS = out + OS_PROJS; float* DTS = out + OS_DTS; bf16* YS = (bf16*)(out + OS_YS);
    float* CS = out + O_YP;
    float* X1 = out + O_YP;
    const int gw = F.vcu * NWAVES + F.wave, NGW = F.G * NWAVES;
    LAS float* redl = (LAS float*)F.lds;

    if (IN(0) && MK_EN(0)) for (int rep_ = 0; rep_ <= MK_DUPK(0); ++rep_) { if (rep_) { REFRESH(); xcd_barrier(bar, F.tid == 0); REFRESH(); }
        ARG(x_prompt, 0);
        ARG(x_sample, 1);
        ARG(norm1_w, 6);
        ARG(w_in, 7);
        ARG(pool_w, 14);
        ARG(w_out, 16);
        ARG(norm2_w, 17);
        ARG(w_up, 18);
        ARG(ffn_conv_w, 19);
        ARG(ffn_conv_b, 20);
        ARG(w_down, 21);
        LAS float* scr = (LAS float*)(F.lds + F.wave * 16640);
        constexpr int I1 = 16 * 56, I2 = 16 * 8, I3 = 32 * 16, I4 = 16 * 88, I5 = 44 * 16, I6 = 16, I7 = 16, NITEMS = I1 + I2 + I3 + I4 + I5 + I6 + I7;
        for (int it = gw; it < NITEMS; it += NGW) {
            int r = it; const float* W; int ldw, k0, ns0, nvalid = 64, nout = 64, K, drow0; bf16* WT; const float* fold = nullptr;
            if (r < I1) { W = w_in; ldw = INC; k0 = 64 * (r / 56); ns0 = 64 * (r % 56); WT = Win_t; K = 1024; drow0 = ns0; }
            else if ((r -= I1) < I2) { W = w_in; ldw = INC; k0 = 64 * (r / 8); ns0 = 3608 + 64 * (r % 8); WT = Win_t; K = 1024; drow0 = 3584 + 64 * (r % 8); }
            else if ((r -= I2) < I3) { W = w_out; ldw = 1024; k0 = 64 * (r / 16); ns0 = 64 * (r % 16); WT = Wout_t; K = 2048; drow0 = ns0; }
            else if ((r -= I3) < I4) { const int j = 64 * (r % 88); W = w_up; ldw = UPN; k0 = 64 * (r / 88); ns0 = j; WT = Wup_t; K = 1024; fold = norm2_w;
                                       drow0 = (j < DFF) ? 256 * (j / 128) + (j % 128) : 256 * ((j - DFF) / 128) + 128 + ((j - DFF) % 128); }
            else if ((r -= I4) < I5) { W = w_down; ldw = 1024; k0 = 64 * (r / 16); ns0 = 64 * (r % 16); WT = Wdn_t; K = DFF; drow0 = ns0; }
            else if ((r -= I5) < I6) { const int g = r >> 2, rr = r & 3; W = pool_w + (size_t)g * 16384; ldw = 128; k0 = 64 * (rr >> 1); ns0 = 64 * (rr & 1); WT = PWt + (size_t)g * 16384; K = 128; drow0 = ns0; }
            else { r -= I6; W = w_in; ldw = INC; k0 = 64 * r; ns0 = 3584; nvalid = 24; nout = 32; WT = Wdt_t; K = 1024; drow0 = 0; }
            transpose_item(W, ldw, k0, ns0, nvalid, nout, WT, K, drow0, fold, scr, F.lane);
        }
        { float* fcw = (float*)(ws + WS_FCW);
          for (int j = F.vcu * NT + F.tid; j < 4 * UPN; j += F.G * NT) fcw[j] = (j < 3 * UPN) ? ffn_conv_w[j] : ffn_conv_b[j - 3 * UPN]; }
        for (int m = 2 * gw; m < MP + NS; m += 2 * NGW) {
            if (m < MP) rms_rows_to_bf16<2>(x_prompt + (size_t)m * DM, norm1_w, XN1 + (size_t)m * DM, F.lane);
            else rms_rows_to_bf16<2>(x_sample + (size_t)(m - MP) * DM, norm1_w, XN1S + (size_t)(m - MP) * DM, F.lane);
        }
        __syncthreads();
    }
    SEAM(0);

    if (IN(1) && MK_EN(1)) for (int rep_ = 0; rep_ <= MK_DUPK(1); ++rep_) { if (rep_) { REFRESH(); xcd_barrier(bar, F.tid == 0); REFRESH(); }
        ARG(dt_bias, 10);
        const int i = F.lane & 15, g4 = F.lane >> 4;
        for (int blk = F.vcu; blk < MP / 64; blk += F.G) {
            const int mt = F.wave >> 1, nt = F.wave & 1;
            const bf16* ap = XN1 + (size_t)(blk * 64 + mt * 16 + i) * DM + 8 * g4; const bf16* bp = Wdt_t + (size_t)(nt * 16 + i) * DM + 8 * g4;
            f32x4 acc = (f32x4){0.f, 0.f, 0.f, 0.f};
#pragma unroll 8
            for (int ks = 0; ks < 32; ++ks) acc = MFMA16(*(const bf16x8*)(ap + 32 * ks), *(const bf16x8*)(bp + 32 * ks), acc);
            const int h = nt * 16 + i;
            if (h < NH) { const float bias = dt_bias[h];
#pragma unroll
                for (int r = 0; r < 4; ++r) DT[(size_t)(blk * 64 + mt * 16 + 4 * g4 + r) * 24 + h] = softplus_f(acc[r] + bias); }
        }
        for (int sl = F.vcu; sl < 256 + 2; sl += F.G) {
            f32x4 acc[8];
            const bool isdt = sl >= 256; const int n0 = isdt ? 16 * (sl - 256) : 16 * sl;
            skinny_acc<8, 1024>(XN1S, isdt ? Wdt_t : Win_t, 0, n0, F.wave, F.lane, acc);
            const f32x4 s = skinny_reduce<8>(redl, acc, F.wave, F.lane, F.tid);
            const int col = n0 + (F.tid & 15), rowb = 16 * (F.tid >> 6) + 4 * ((F.tid & 63) >> 4);
            if (!isdt) {
#pragma unroll
                for (int r = 0; r < 4; ++r) PROJS[(size_t)(rowb + r) * NPROJ + col] = s[r]; }
            else if (col < NH) { const float bias = dt_bias[col];
#pragma unroll
                for (int r = 0; r < 4; ++r) DTS[(rowb + r) * 24 + col] = softplus_f(s[r] + bias); }
        }
        __syncthreads();
        pg8::Gemm gm{XN1, Win_t, MP, NPROJ, DM}; pg8::StaticOrder S; S.init(MP, NPROJ, F.G, (int)blockIdx.x);
        pg8::EpiStoreBf16 E{PROJ, NPROJ};
        pg8::gemm_phase<pg8::EpiStoreBf16, pg8::StaticOrder, true, true>(F.lds + RING_OFF, gm, S, E, F.tid);
    }
    SEAM(1);

    if (IN(2) && MK_EN(2)) for (int rep_ = 0; rep_ <= MK_DUPK(2); ++rep_) { if (rep_) { REFRESH(); xcd_barrier(bar, F.tid == 0); REFRESH(); }
        constexpr int NU0 = 512 + 512 + 512 + 128, NUX = ((MK_P2DUP & 1) ? 512 : 0) + ((MK_P2DUP & 2) ? 512 : 0) + ((MK_P2DUP & 4) ? 512 : 0) + ((MK_P2DUP & 8) ? 128 : 0);
        for (int u0 = F.vcu; u0 < NU0 + NUX; u0 += F.G) {
            int u = u0;
            if (u >= NU0) u = (MK_P2DUP & 1) ? u - NU0 : (MK_P2DUP & 2) ? u - NU0 + 512 : (MK_P2DUP & 4) ? u - NU0 + 1024 : u - NU0 + 1536;
            if (u < 512) s1_unit(F, PROJ, DT, CS, CDEC, out + O_CONVP, u);
            else if (u < 1024) pool_unit(F, PROJ, PWt, Y, out + O_POOLP, u - 512);
            else if (u < 1536) ssm_sample_unit(F, out, u - 1024);
            else pool_sample_unit(F, out, u - 1536);
        }
    }
    SEAM(2);

    if (IN(3) && MK_EN(3)) for (int rep_ = 0; rep_ <= MK_DUPK(3); ++rep_) { if (rep_) { REFRESH(); xcd_barrier(bar, F.tid == 0); REFRESH(); }
        ARG(x_sample, 1);
        ARG(w_out, 16);
        ARG(norm2_w, 17);
        for (int it = F.vcu * NT + F.tid; it < NB * NH * 64 * 16; it += F.G * NT) {
            const int n4 = it & 15, p = (it >> 4) & 63, hh = (it >> 10) % NH, b = (it >> 10) / NH;
            f32x4 cs[16];
#pragma unroll
            for (int c = 0; c < 16; ++c) cs[c] = *(const f32x4*)(CS + ((((size_t)b * 16 + c) * NH + hh) * 64 + p) * 64 + 4 * n4);
            f32x4 h = (f32x4){0.f, 0.f, 0.f, 0.f};
#pragma unroll
            for (int c = 0; c < 16; ++c) { v2u pk; pk.x = cvt_pk_bf16(h[0], h[1]); pk.y = cvt_pk_bf16(h[2], h[3]);
                *(v2u*)(HIN + ((((size_t)b * 16 + c) * NH + hh) * 64 + p) * 64 + 4 * n4) = pk;
                h = h * CDEC[(b * 16 + c) * NH + hh] + cs[c]; }
            *(f32x4*)(out + O_SSMP + (((size_t)b * NH + hh) * 64 + p) * 64 + 4 * n4) = h;
        }
        for (int sl = F.vcu; sl < 256; sl += F.G) {
            const int rt = sl >> 6, nt = sl & 63; f32x4 acc[2];
            skinny_acc<2, 2048>(YS, Wout_t, 32 * rt, 16 * nt, F.wave, F.lane, acc);
            const f32x4 s = skinny_reduce<2>(redl, acc, F.wave, F.lane, F.tid);
            if ((F.tid >> 6) < 2) { const int col = 16 * nt + (F.tid & 15), rowb = 32 * rt + 16 * (F.tid >> 6) + 4 * ((F.tid & 63) >> 4);
#pragma unroll
                for (int r = 0; r < 4; ++r) X1S[(size_t)(rowb + r) * DM + col] = s[r] + x_sample[(size_t)(rowb + r) * DM + col]; }
        }
    }
    SEAM(3);

    if (IN(4) && MK_EN(4)) for (int rep_ = 0; rep_ <= MK_DUPK(4); ++rep_) { if (rep_) { REFRESH(); xcd_barrier(bar, F.tid == 0); REFRESH(); }
        for (int u = F.vcu; u < 512; u += F.G) s3_unit(F, PROJ, DT, HIN, Y, u);
        for (int m = gw; m < NS; m += NGW) rms_row_to_bf16(X1S + (size_t)m * DM, nullptr, XN2S + (size_t)m * DM, F.lane);
    }
    SEAM(4);

    if (IN(5) && MK_EN(5)) for (int rep_ = 0; rep_ <= MK_DUPK(5); ++rep_) { if (rep_) { REFRESH(); xcd_barrier(bar, F.tid == 0); REFRESH(); }
        ARG(x_prompt, 0);
        ARG(state_ffn, 5);
        ARG(ffn_conv_w, 19);
        ARG(ffn_conv_b, 20);
        for (int sl = F.vcu; sl < 352; sl += F.G) {
            const int rt = sl / 176, ct = sl % 176, c0 = 16 * ct, ng0 = 256 * (c0 >> 7) + (c0 & 127);
            f32x4 acc[4];
            skinny_acc<4, 1024>(XN2S, Wup_t, 64 * rt, ng0, F.wave, F.lane, acc);
            const f32x4 sg = skinny_reduce<4>(redl, acc, F.wave, F.lane, F.tid);
            skinny_acc<4, 1024>(XN2S, Wup_t, 64 * rt, ng0 + 128, F.wave, F.lane, acc);
            const f32x4 sv = skinny_reduce<4>(redl, acc, F.wave, F.lane, F.tid);
            if ((F.tid >> 6) < 4) { const int ch = c0 + (F.tid & 15), rowb = 64 * rt + 16 * (F.tid >> 6) + 4 * ((F.tid & 63) >> 4);
                const float wg0 = ffn_conv_w[ch], wg1 = ffn_conv_w[UPN + ch], wg2 = ffn_conv_w[2 * UPN + ch], bg = ffn_conv_b[ch];
                const float wv0 = ffn_conv_w[DFF + ch], wv1 = ffn_conv_w[UPN + DFF + ch], wv2 = ffn_conv_w[2 * UPN + DFF + ch], bv = ffn_conv_b[DFF + ch];
#pragma unroll
                for (int r = 0; r < 4; ++r) { const int bb = rowb + r; const float* st = state_ffn + (size_t)bb * 2 * UPN; float* fo = out + O_FFNS + (size_t)bb * 2 * UPN;
                    const float g0 = st[ch], g1 = st[UPN + ch], v0 = st[DFF + ch], v1 = st[UPN + DFF + ch];
                    const float ug = bg + wg0 * g0 + wg1 * g1 + wg2 * sg[r], uv = bv + wv0 * v0 + wv1 * v1 + wv2 * sv[r];
                    HS[(size_t)bb * DFF + ch] = f2bf(silu_f(ug) * uv);
                    fo[ch] = g1; fo[UPN + ch] = sg[r]; fo[DFF + ch] = v1; fo[UPN + DFF + ch] = sv[r]; } }
        }
        __syncthreads();
        pg8::Gemm gm{Y, Wout_t, MP, DM, DMIX}; pg8::StaticOrder S; S.init(MP, DM, F.G, (int)blockIdx.x);
        pg8::EpiResid<0> E{x_prompt, X1b, SSP};
        pg8::gemm_phase<pg8::EpiResid<0>, pg8::StaticOrder, true, true>(F.lds + RING_OFF, gm, S, E, F.tid);
    }
    SEAM(5);

    if (IN(6) && MK_EN(6)) for (int rep_ = 0; rep_ <= MK_DUPK(6); ++rep_) { if (rep_) { REFRESH(); xcd_barrier(bar, F.tid == 0); REFRESH(); }
        ARG(w_down, 21);
        for (int sl = F.vcu; sl < 256; sl += F.G) {
            const int rt = sl >> 6, nt = sl & 63; f32x4 acc[2];
            skinny_acc<2, 2816>(HS, Wdn_t, 32 * rt, 16 * nt, F.wave, F.lane, acc);
            const f32x4 s = skinny_reduce<2>(redl, acc, F.wave, F.lane, F.tid);
            if ((F.tid >> 6) < 2) { const int col = 16 * nt + (F.tid & 15), rowb = 32 * rt + 16 * (F.tid >> 6) + 4 * ((F.tid & 63) >> 4);
#pragma unroll
                for (int r = 0; r < 4; ++r) X2S[(size_t)(rowb + r) * DM + col] = s[r] + X1S[(size_t)(rowb + r) * DM + col]; }
        }
        __syncthreads();
        pg8::Gemm gm{X1b, Wup_t, MP, UPN, DM}; pg8::UpOrder S; S.init(MP, UPN, F.G, (int)blockIdx.x);
        S.fcw = (const float*)(ws + WS_FCW); S.lds = F.lds; S.wid = F.wave; S.k_ = 0;
        { pg8::Unit u; LAS float* RS = (LAS float*)(F.lds + pg8::UP_RS);
          for (int ui = 0; ui < 8 && S.next(ui, u); ++ui)
              for (int r = F.tid; r < 256; r += NT) { const f32x4* pp = (const f32x4*)(SSP + (size_t)(u.pm * 256 + r) * 16); const f32x4 p0 = pp[0], p1 = pp[1], p2 = pp[2], p3 = pp[3];
                  const float sq = ((p0[0] + p0[1]) + (p0[2] + p0[3])) + ((p1[0] + p1[1]) + (p1[2] + p1[3])) + ((p2[0] + p2[1]) + (p2[2] + p2[3])) + ((p3[0] + p3[1]) + (p3[2] + p3[3]));
                  RS[ui * 256 + r] = __builtin_amdgcn_rsqf(sq * (1.0f / 1024.0f) + EPS); } }
        __syncthreads();
#if MK_P6DUP
        { pg8::StaticOrder S0; S0.init(MP, UPN, F.G, (int)blockIdx.x); pg8::EpiNull E0{(float*)(ws + WS_Y)};
          pg8::gemm_phase<pg8::EpiNull, pg8::StaticOrder, true, true>(F.lds + RING_OFF, gm, S0, E0, F.tid); REFRESH(); xcd_barrier(bar, F.tid == 0); REFRESH(); }
#endif
        typedef pg8::EpiUp<WS_B + WB_H, WS_B + WB_UT, WS_B + WB_UH> EpiUpT;
        EpiUpT E{ws, out + O_FFNP, F.lds, 0};
        pg8::gemm_phase<EpiUpT, pg8::UpOrder, true, true>(F.lds + RING_OFF, gm, S, E, F.tid);
    }
    SEAM(6);

    if (IN(7) && MK_EN(7)) for (int rep_ = 0; rep_ <= MK_DUPK(7); ++rep_) { if (rep_) { REFRESH(); xcd_barrier(bar, F.tid == 0); REFRESH(); }
        ARG(ffn_conv_w, 19);
        ARG(ffn_conv_b, 20);
        ARG(final_norm_w, 22);
        for (int m = gw; m < NS; m += NGW) {
            const f32x4* xr = (const f32x4*)(X2S + (size_t)m * DM) + F.lane; f32x4 v[4]; float s = 0.f;
#pragma unroll
            for (int j = 0; j < 4; ++j) { v[j] = xr[64 * j]; s += (v[j][0] * v[j][0] + v[j][1] * v[j][1]) + (v[j][2] * v[j][2] + v[j][3] * v[j][3]); }
            const float rs = 1.0f / sqrtf(wave_sum(s) * (1.0f / 1024.0f) + EPS);
            f32x4* yo = (f32x4*)(out + O_YS + (size_t)m * DM) + F.lane;
#pragma unroll
            for (int j = 0; j < 4; ++j) yo[64 * j] = v[j] * rs * ((const f32x4*)final_norm_w)[F.lane + 64 * j];
        }
        pg8::StaticOrder S; S.init(MP, DM, F.G, (int)blockIdx.x);
        { pg8::Unit u;
          for (int ui = 0; S.next(ui, u); ++ui) { const int pm = u.pm; if ((pm & 7) == 0) continue;
            for (int j = F.tid; j < DFF; j += NT) { const int gi = 256 * (j >> 7) + (j & 127), vi = gi + 128;
                const float* t0 = UT + (size_t)(pm - 1) * 2 * UPN; const float* h0 = UH + (size_t)pm * 2 * UPN;
                const float gm2 = t0[gi], gm1 = t0[UPN + gi], g0 = h0[gi], g1 = h0[UPN + gi];
                const float vm2 = t0[vi], vm1 = t0[UPN + vi], v0 = h0[vi], v1 = h0[UPN + vi];
                const float wg0 = ffn_conv_w[j], wg1 = ffn_conv_w[UPN + j], wg2 = ffn_conv_w[2 * UPN + j], bg = ffn_conv_b[j];
                const float wv0 = ffn_conv_w[DFF + j], wv1 = ffn_conv_w[UPN + DFF + j], wv2 = ffn_conv_w[2 * UPN + DFF + j], bv = ffn_conv_b[DFF + j];
                const float ug0 = bg + wg0 * gm2 + wg1 * gm1 + wg2 * g0, ug1 = bg + wg0 * gm1 + wg1 * g0 + wg2 * g1;
                const float uv0 = bv + wv0 * vm2 + wv1 * vm1 + wv2 * v0, uv1 = bv + wv0 * vm1 + wv1 * v0 + wv2 * v1;
                Hb[(size_t)(256 * pm) * DFF + j] = f2bf(silu_f(ug0) * uv0); Hb[(size_t)(256 * pm + 1) * DFF + j] = f2bf(silu_f(ug1) * uv1); } } }
        VM_WAIT(); __syncthreads();
        pg8::Gemm gm{Hb, Wdn_t, MP, DM, DFF};
#if MK_P7DUP
        { pg8::EpiResid<1> E0{X1b, (float*)(ws + WS_Y), SSP2}; pg8::gemm_phase<pg8::EpiResid<1>, pg8::StaticOrder, true, true>(F.lds + RING_OFF, gm, S, E0, F.tid); REFRESH(); xcd_barrier(bar, F.tid == 0); REFRESH(); }
#endif
        pg8::EpiResid<1> E{X1b, X1, SSP2};
        pg8::gemm_phase<pg8::EpiResid<1>, pg8::StaticOrder, true, true>(F.lds + RING_OFF, gm, S, E, F.tid);
    }
    SEAM(7);

    if (IN(8) && MK_EN(8)) for (int rep_ = 0; rep_ <= MK_DUPK(8); ++rep_) { if (rep_) { REFRESH(); xcd_barrier(bar, F.tid == 0); REFRESH(); }
        ARG(final_norm_w, 22);
#if MK_P8DUP
        for (int m = gw; m < MP; m += NGW) {
            f32x4* xr = (f32x4*)(out + O_YP + (size_t)m * DM) + F.lane; f32x4* xw = (f32x4*)((float*)(ws + WS_Y) + (size_t)m * DM) + F.lane; f32x4 v[4];
#pragma unroll
            for (int j = 0; j < 4; ++j) v[j] = xr[64 * j];
            const f32x4* pp = (const f32x4*)(SSP2 + (size_t)m * 16); const f32x4 p0 = pp[0], p1 = pp[1], p2 = pp[2], p3 = pp[3];
            const float s = ((p0[0] + p0[1]) + (p0[2] + p0[3])) + ((p1[0] + p1[1]) + (p1[2] + p1[3])) + ((p2[0] + p2[1]) + (p2[2] + p2[3])) + ((p3[0] + p3[1]) + (p3[2] + p3[3]));
            const float rs = 1.0f / sqrtf(s * (1.0f / 1024.0f) + EPS);
#pragma unroll
            for (int j = 0; j < 4; ++j) xw[64 * j] = v[j] * rs * ((const f32x4*)final_norm_w)[F.lane + 64 * j];
        }
        REFRESH(); xcd_barrier(bar, F.tid == 0); REFRESH();
#endif
        for (int m = gw; m < MP; m += NGW) {
            f32x4* xr = (f32x4*)(out + O_YP + (size_t)m * DM) + F.lane; f32x4 v[4];
#pragma unroll
            for (int j = 0; j < 4; ++j) v[j] = xr[64 * j];
            const f32x4* pp = (const f32x4*)(SSP2 + (size_t)m * 16); const f32x4 p0 = pp[0], p1 = pp[1], p2 = pp[2], p3 = pp[3];
            const float s = ((p0[0] + p0[1]) + (p0[2] + p0[3])) + ((p1[0] + p1[1]) + (p1[2] + p1[3])) + ((p2[0] + p2[1]) + (p2[2] + p2[3])) + ((p3[0] + p3[1]) + (p3[2] + p3[3]));
            const float rs = 1.0f / sqrtf(s * (1.0f / 1024.0f) + EPS);
#pragma unroll
            for (int j = 0; j < 4; ++j) xr[64 * j] = v[j] * rs * ((const f32x4*)final_norm_w)[F.lane + 64 * j];
        }
    }
#undef IN
#undef SEAM
}
}

#ifndef MK_PER_PHASE
#define MK_PER_PHASE 0
#endif
extern "C" void kernel_launch(void* const* d_in, const int* in_sizes, int n_in, void* d_out, int out_size, void* d_ws, size_t ws_size, hipStream_t stream) {
    using namespace mk;
    static int grid = 0;
    if (grid == 0) {
        if (n_in != 23 || in_sizes[0] != MP * DM || out_size != (int)O_END || ws_size < WS_END) {
            fprintf(stderr, "kernel_launch: unexpected problem (n_in %d, in0 %d, out %d, ws %zu); nothing launched\n", n_in, n_in > 0 ? in_sizes[0] : -1, out_size, ws_size); grid = -1; return; }
        int dev = 0, cus = 0, per_cu = 0;
        if (hipGetDevice(&dev) != hipSuccess || hipDeviceGetAttribute(&cus, hipDeviceAttributeMultiprocessorCount, dev) != hipSuccess) { fprintf(stderr, "kernel_launch: device query failed\n"); grid = -1; return; }
#if MK_PER_PHASE
        const void* fns[9] = {(const void*)mk_fwd<1>, (const void*)mk_fwd<2>, (const void*)mk_fwd<4>, (const void*)mk_fwd<8>, (const void*)mk_fwd<16>, (const void*)mk_fwd<32>, (const void*)mk_fwd<64>, (const void*)mk_fwd<128>, (const void*)mk_fwd<256>};
        const int nfn = 9;
#else
        const void* fns[1] = {(const void*)mk_fwd<0x1FF>};
        const int nfn = 1;
#endif
        for (int i = 0; i < nfn; ++i)
            if (hipFuncSetAttribute(fns[i], hipFuncAttributeMaxDynamicSharedMemorySize, LDS_BYTES) != hipSuccess) { fprintf(stderr, "kernel_launch: hipFuncSetAttribute(%d B LDS) failed\n", LDS_BYTES); grid = -1; return; }
        if (hipOccupancyMaxActiveBlocksPerMultiprocessor(&per_cu, fns[0], NT, LDS_BYTES) != hipSuccess || per_cu < 1) {
            fprintf(stderr, "kernel_launch: occupancy query reports %d workgroups per CU; nothing launched\n", per_cu); (void)hipGetLastError(); grid = -1; return; }
        grid = cus;
    }
    if (grid < 0) return;
    if (hipMemsetAsync((char*)d_ws + WS_CTL, 0, CTL_BYTES, stream) != hipSuccess) { fprintf(stderr, "kernel_launch: memset failed\n"); return; }
    Args a{};
    for (int i = 0; i < 23; ++i) a.in[i] = (const float*)d_in[i];
    a.out = (float*)d_out; a.ws = (unsigned char*)d_ws;
#if MK_PER_PHASE
#define MK_LAUNCH(p) do { a.ph_lo = p; a.ph_hi = p + 1; hipLaunchKernelGGL(mk_fwd<(1 << p)>, dim3(grid), dim3(NT), LDS_BYTES, stream, a); } while (0)
    MK_LAUNCH(0); MK_LAUNCH(1); MK_LAUNCH(2); MK_LAUNCH(3); MK_LAUNCH(4); MK_LAUNCH(5); MK_LAUNCH(6); MK_LAUNCH(7); MK_LAUNCH(8);
#else
    a.ph_lo = 0; a.ph_hi = NPHASE;
    hipLaunchKernelGGL(mk_fwd<0x1FF>, dim3(grid), dim3(NT), LDS_BYTES, stream, a);
#endif
    const hipError_t le = hipPeekAtLastError();
    if (le != hipSuccess) fprintf(stderr, "kernel_launch: launch failed: %s\n", hipGetErrorName(le));
}
```
